# Optimizing an MI355X kernel written in HIP

```python
import jax, jax.numpy as jnp
from jax import lax
import numpy as np

D_MODEL = 2048
BATCH = 1
SEQ = 8192
DEPTH = 2

GRID_W = 64
CTX_LEN = 256
EPS = 1e-6
ROPE_THETA = 10000.0
Q_BLOCK = 128
HEAD_DIM = 128
NA_HEADS = 8
NA_KH = 8
NA_KW = 16
MLA_HEADS = 8
MLA_Q_RANK = 512
MLA_KV_RANK = 512
MLA_NOPE = 128
MLA_ROPE = 64
MLA_V = 128
EVEN_IN_WIDTHS = (NA_HEADS * HEAD_DIM, NA_HEADS * HEAD_DIM, NA_HEADS * HEAD_DIM, MLA_Q_RANK, MLA_KV_RANK, MLA_ROPE)
EVEN_OUT_WIDTH = NA_HEADS * HEAD_DIM + MLA_HEADS * MLA_V
GQA_HEADS = 16
GQA_KV = 4
GQA_GROUP = GQA_HEADS // GQA_KV
N_EXPERTS = 64
N_GROUPS = 8
TOPK_GROUPS = 4
MOE_TOP_K = 8
D_EXPERT = 512
D_SHARED = 512
ROUTED_SCALE = 2.5
EXPERT_BLOCK = 128
N_EVEN = (DEPTH + 1) // 2
N_ODD = DEPTH // 2

kernel_name = 'hybrid_na_mla_gqa_moe_dit'


def rmsnorm(x, g):
    xf = x.astype(jnp.float32)
    y = xf * lax.rsqrt(jnp.mean(xf * xf, axis=-1, keepdims=True) + EPS)
    return y.astype(x.dtype) * g


def modulate(x, shift, scale):
    return x * (1 + scale) + shift


def to_heads(t, n):
    B, T, _ = t.shape
    return t.reshape(B, T, n, -1).transpose(0, 2, 1, 3)


def from_heads(o):
    B, H, T, d = o.shape
    return o.transpose(0, 2, 1, 3).reshape(B, T, H * d)


def rope_tables(S, d):
    t = jnp.arange(S)
    row = (t // GRID_W).astype(jnp.float32)
    col = (t % GRID_W).astype(jnp.float32)
    n = d // 4
    inv = ROPE_THETA ** (-jnp.arange(n, dtype=jnp.float32) / n)
    ang = jnp.concatenate([row[:, None] * inv, col[:, None] * inv], axis=-1)
    ang = jnp.concatenate([jnp.zeros((CTX_LEN, d // 2), jnp.float32), ang], axis=0)
    return jnp.cos(ang), jnp.sin(ang)


def apply_rope(x, cos, sin):
    cos = cos.astype(x.dtype)
    sin = sin.astype(x.dtype)
    x1, x2 = x[..., 0::2], x[..., 1::2]
    return jnp.stack([x1 * cos - x2 * sin, x1 * sin + x2 * cos], axis=-1).reshape(x.shape)


def attend_blocks(q, k, v, scale):
    B, Hk, G, Sq, dk = q.shape
    nb = Sq // Q_BLOCK
    qb = q.reshape(B, Hk, G, nb, Q_BLOCK, dk).transpose(3, 0, 1, 2, 4, 5)

    def one(qi):
        s = jnp.einsum('bkgqd,bksd->bkgqs', qi, k).astype(jnp.float32) * scale
        p = jax.nn.softmax(s, axis=-1).astype(v.dtype)
        return jnp.einsum('bkgqs,bksd->bkgqd', p, v)

    o = lax.map(one, qb)
    return o.transpose(1, 2, 3, 0, 4, 5).reshape(B, Hk, G, Sq, v.shape[-1])


def neighbourhood_attention(q, k, v, rpb, k_ctx, v_ctx):
    B, H, S, dh = q.shape
    rows = S // GRID_W
    kh = min(NA_KH, rows)
    scale = dh ** -0.5
    qg = q.reshape(B, H, rows, GRID_W, dh)
    kg = k.reshape(B, H, rows, GRID_W, dh)
    vg = v.reshape(B, H, rows, GRID_W, dh)
    cols = jnp.arange(GRID_W)
    c0 = jnp.clip(cols - NA_KW // 2, 0, GRID_W - NA_KW)
    col_idx = c0[:, None] + jnp.arange(NA_KW)
    col_rel = col_idx - cols[:, None] + NA_KW - 1

    def row_block(r):
        r0 = jnp.clip(r - kh // 2, 0, rows - kh)
        q_r = lax.dynamic_index_in_dim(qg, r, axis=2, keepdims=False)
        k_win = lax.dynamic_slice_in_dim(kg, r0, kh, axis=2)[:, :, :, col_idx]
        v_win = lax.dynamic_slice_in_dim(vg, r0, kh, axis=2)[:, :, :, col_idx]
        row_rel = r0 + jnp.arange(kh) - r + NA_KH - 1
        bias = rpb[:, row_rel][:, :, col_rel].transpose(0, 2, 1, 3)
        s_loc = jnp.einsum('bhwd,bhiwjd->bhwij', q_r, k_win).astype(jnp.float32) * scale + bias.astype(jnp.float32)
        s_ctx = jnp.einsum('bhwd,bhld->bhwl', q_r, k_ctx).astype(jnp.float32) * scale
        s = jnp.concatenate([s_loc.reshape(B, H, GRID_W, kh * NA_KW), s_ctx], axis=-1)
        p = jax.nn.softmax(s, axis=-1).astype(v.dtype)
        p_loc = p[..., :kh * NA_KW].reshape(B, H, GRID_W, kh, NA_KW)
        p_ctx = p[..., kh * NA_KW:]
        return jnp.einsum('bhwij,bhiwjd->bhwd', p_loc, v_win) + jnp.einsum('bhwl,bhld->bhwd', p_ctx, v_ctx)

    o = lax.map(row_block, jnp.arange(rows))
    return o.transpose(1, 2, 0, 3, 4).reshape(B, H, S, dh)


def mixer_even(h, need_ctx, w_in, rpb, q_norm, w_uq, kv_norm, w_ukv, w_out):
    B, T, _ = h.shape
    L = CTX_LEN
    S = T - L
    splits = np.cumsum(EVEN_IN_WIDTHS)[:-1].tolist()
    qa, ka, va, cq, ckv, kr = jnp.split(h @ w_in, splits, axis=-1)
    qa, ka, va = to_heads(qa, NA_HEADS), to_heads(ka, NA_HEADS), to_heads(va, NA_HEADS)
    o_na = neighbourhood_attention(qa[:, :, L:], ka[:, :, L:], va[:, :, L:], rpb, ka[:, :, :L], va[:, :, :L])
    cos, sin = rope_tables(S, MLA_ROPE)
    q = to_heads(rmsnorm(cq, q_norm) @ w_uq, MLA_HEADS)
    kv = to_heads(rmsnorm(ckv, kv_norm) @ w_ukv, MLA_HEADS)
    q = jnp.concatenate([q[..., :MLA_NOPE], apply_rope(q[..., MLA_NOPE:], cos, sin)], axis=-1)
    k_rope = apply_rope(kr, cos, sin)[:, None]
    k = jnp.concatenate([kv[..., :MLA_NOPE], jnp.broadcast_to(k_rope, (B, MLA_HEADS, T, MLA_ROPE))], axis=-1)
    v = kv[..., MLA_NOPE:]
    mla_scale = (MLA_NOPE + MLA_ROPE) ** -0.5
    o_mla = attend_blocks(q[:, :, None, L:], k, v, mla_scale)[:, :, 0]
    if need_ctx:
        o_na_c = attend_blocks(qa[:, :, None, :L], ka[:, :, :L], va[:, :, :L], HEAD_DIM ** -0.5)[:, :, 0]
        o_mla_c = attend_blocks(q[:, :, None, :L], k[:, :, :L], v[:, :, :L], mla_scale)[:, :, 0]
        o_na = jnp.concatenate([o_na_c, o_na], axis=2)
        o_mla = jnp.concatenate([o_mla_c, o_mla], axis=2)
    o = jnp.concatenate([from_heads(o_na), from_heads(o_mla)], axis=-1)
    return o @ w_out


def mixer_odd(h, need_ctx, w_qkv, q_norm, k_norm, w_o):
    B, T, _ = h.shape
    L = CTX_LEN
    S = T - L
    q, k, v = jnp.split(h @ w_qkv, [GQA_HEADS * HEAD_DIM, (GQA_HEADS + GQA_KV) * HEAD_DIM], axis=-1)
    cos, sin = rope_tables(S, HEAD_DIM)
    q = apply_rope(rmsnorm(to_heads(q, GQA_HEADS), q_norm), cos, sin)
    k = apply_rope(rmsnorm(to_heads(k, GQA_KV), k_norm), cos, sin)
    v = to_heads(v, GQA_KV)
    q = q.reshape(B, GQA_KV, GQA_GROUP, T, HEAD_DIM)
    scale = HEAD_DIM ** -0.5
    o = attend_blocks(q[:, :, :, L:], k, v, scale)
    if need_ctx:
        o_c = attend_blocks(q[:, :, :, :L], k[:, :, :L], v[:, :, :L], scale)
        o = jnp.concatenate([o_c, o], axis=3)
    o = o.reshape(B, GQA_HEADS, -1, HEAD_DIM)
    return from_heads(o) @ w_o


def swiglu(x, wg, wu, wd):
    return (jax.nn.silu(x @ wg) * (x @ wu)) @ wd


def routed_experts(xf, eidx, ew, w_gate, w_up, w_down):
    N, D = xf.shape
    A = N * MOE_TOP_K
    e_flat = eidx.reshape(-1)
    order = jnp.argsort(e_flat)
    e_sorted = e_flat[order]
    tok_sorted = (order // MOE_TOP_K).astype(jnp.int32)
    w_sorted = ew.reshape(-1)[order]
    counts = jnp.bincount(e_flat, length=N_EXPERTS)
    padded = (counts + EXPERT_BLOCK - 1) // EXPERT_BLOCK * EXPERT_BLOCK
    pad_end = jnp.cumsum(padded)
    pad_start = pad_end - padded
    start = jnp.cumsum(counts) - counts
    dest = pad_start[e_sorted] + jnp.arange(A) - start[e_sorted]
    n_blocks = -(-A // EXPERT_BLOCK) + N_EXPERTS
    P = n_blocks * EXPERT_BLOCK
    tok_buf = jnp.full((P,), N, jnp.int32).at[dest].set(tok_sorted)
    w_buf = jnp.zeros((P,), xf.dtype).at[dest].set(w_sorted)
    block_expert = jnp.minimum(jnp.searchsorted(pad_end, jnp.arange(n_blocks) * EXPERT_BLOCK, side='right'), N_EXPERTS - 1)
    xpad = jnp.concatenate([xf, jnp.zeros((1, D), xf.dtype)], axis=0)

    def run_block(args):
        tok, e = args
        return swiglu(xpad[tok], w_gate[e], w_up[e], w_down[e])

    y = lax.map(run_block, (tok_buf.reshape(n_blocks, EXPERT_BLOCK), block_expert))
    y = y.reshape(P, D) * w_buf[:, None]
    return jax.ops.segment_sum(y, tok_buf, num_segments=N + 1)[:N]


def moe(h, router_w, router_b, w_gate, w_up, w_down, sh_gate, sh_up, sh_down):
    B, T, D = h.shape
    xf = h.reshape(B * T, D)
    N = xf.shape[0]
    scores = jax.nn.sigmoid((xf @ router_w).astype(jnp.float32))
    sel = scores + router_b.astype(jnp.float32)
    group_score = lax.top_k(sel.reshape(N, N_GROUPS, N_EXPERTS // N_GROUPS), 2)[0].sum(-1)
    _, gidx = lax.top_k(group_score, TOPK_GROUPS)
    gmask = jax.nn.one_hot(gidx, N_GROUPS, dtype=jnp.float32).sum(1) > 0
    emask = jnp.repeat(gmask, N_EXPERTS // N_GROUPS, axis=1)
    _, eidx = lax.top_k(jnp.where(emask, sel, -jnp.inf), MOE_TOP_K)
    ew = jnp.take_along_axis(scores, eidx, axis=-1)
    ew = (ew / jnp.sum(ew, axis=-1, keepdims=True) * ROUTED_SCALE).astype(xf.dtype)
    out = routed_experts(xf, eidx, ew, w_gate, w_up, w_down) + swiglu(xf, sh_gate, sh_up, sh_down)
    return out.reshape(B, T, D)


def setup_inputs(seed: int = 0) -> dict:
    key = jax.random.key(seed)
    ks = iter(jax.random.split(key, 40))
    D = D_MODEL

    def nrm(shape, scale):
        return jax.random.normal(next(ks), shape, jnp.float32) * scale

    def gain(shape):
        return 1.0 + nrm(shape, 0.05)

    return {
        'x': nrm((BATCH, SEQ, D), 1.0),
        'c': nrm((BATCH, D), 1.0),
        'ctx': nrm((BATCH, CTX_LEN, D), 1.0),
        'c_ctx': nrm((D,), 1.0),
        'ada_w': nrm((DEPTH, D, 6 * D), 0.5 * D ** -0.5),
        'ada_b': nrm((DEPTH, 6 * D), 0.02),
        'mix_norm': gain((DEPTH, D)),
        'ffn_norm': gain((DEPTH, D)),
        'ev_w_in': nrm((N_EVEN, D, sum(EVEN_IN_WIDTHS)), D ** -0.5),
        'ev_rpb': nrm((N_EVEN, NA_HEADS, 2 * NA_KH - 1, 2 * NA_KW - 1), 0.1),
        'ev_q_norm': gain((N_EVEN, MLA_Q_RANK)),
        'ev_w_uq': nrm((N_EVEN, MLA_Q_RANK, MLA_HEADS * (MLA_NOPE + MLA_ROPE)), MLA_Q_RANK ** -0.5),
        'ev_kv_norm': gain((N_EVEN, MLA_KV_RANK)),
        'ev_w_ukv': nrm((N_EVEN, MLA_KV_RANK, MLA_HEADS * (MLA_NOPE + MLA_V)), MLA_KV_RANK ** -0.5),
        'ev_w_out': nrm((N_EVEN, EVEN_OUT_WIDTH, D), EVEN_OUT_WIDTH ** -0.5),
        'od_w_qkv': nrm((N_ODD, D, (GQA_HEADS + 2 * GQA_KV) * HEAD_DIM), D ** -0.5),
        'od_q_norm': gain((N_ODD, HEAD_DIM)),
        'od_k_norm': gain((N_ODD, HEAD_DIM)),
        'od_w_o': nrm((N_ODD, GQA_HEADS * HEAD_DIM, D), (GQA_HEADS * HEAD_DIM) ** -0.5),
        'router_w': nrm((DEPTH, D, N_EXPERTS), D ** -0.5),
        'router_b': nrm((DEPTH, N_EXPERTS), 0.01),
        'exp_w_gate': nrm((DEPTH, N_EXPERTS, D, D_EXPERT), D ** -0.5),
        'exp_w_up': nrm((DEPTH, N_EXPERTS, D, D_EXPERT), D ** -0.5),
        'exp_w_down': nrm((DEPTH, N_EXPERTS, D_EXPERT, D), D_EXPERT ** -0.5),
        'sh_w_gate': nrm((DEPTH, D, D_SHARED), D ** -0.5),
        'sh_w_up': nrm((DEPTH, D, D_SHARED), D ** -0.5),
        'sh_w_down': nrm((DEPTH, D_SHARED, D), D_SHARED ** -0.5),
        'final_norm': gain((D,)),
    }


def reference(x, c, ctx, c_ctx, ada_w, ada_b, mix_norm, ffn_norm, ev_w_in, ev_rpb, ev_q_norm, ev_w_uq, ev_kv_norm, ev_w_ukv, ev_w_out, od_w_qkv, od_q_norm, od_k_norm, od_w_o, router_w, router_b, exp_w_gate, exp_w_up, exp_w_down, sh_w_gate, sh_w_up, sh_w_down, final_norm):
    S = x.shape[1]
    L = CTX_LEN
    x_lat, x_ctx = x, ctx
    for i in range(DEPTH):
        last = i == DEPTH - 1
        j = i // 2
        m_l = jnp.split((jax.nn.silu(c) @ ada_w[i] + ada_b[i])[:, None, :], 6, axis=-1)
        m_c = jnp.split(jax.nn.silu(c_ctx) @ ada_w[i] + ada_b[i], 6, axis=-1)
        h = jnp.concatenate([modulate(rmsnorm(x_ctx, mix_norm[i]), m_c[0], m_c[1]),
                             modulate(rmsnorm(x_lat, mix_norm[i]), m_l[0], m_l[1])], axis=1)
        if i % 2 == 0:
            o = mixer_even(h, not last, ev_w_in[j], ev_rpb[j], ev_q_norm[j], ev_w_uq[j], ev_kv_norm[j], ev_w_ukv[j], ev_w_out[j])
        else:
            o = mixer_odd(h, not last, od_w_qkv[j], od_q_norm[j], od_k_norm[j], od_w_o[j])
        x_lat = x_lat + m_l[2] * o[:, -S:]
        h_lat = modulate(rmsnorm(x_lat, ffn_norm[i]), m_l[3], m_l[4])
        moe_p = (router_w[i], router_b[i], exp_w_gate[i], exp_w_up[i], exp_w_down[i], sh_w_gate[i], sh_w_up[i], sh_w_down[i])
        if last:
            x_lat = x_lat + m_l[5] * moe(h_lat, *moe_p)
        else:
            x_ctx = x_ctx + m_c[2] * o[:, :L]
            h_ctx = modulate(rmsnorm(x_ctx, ffn_norm[i]), m_c[3], m_c[4])
            f = moe(jnp.concatenate([h_ctx, h_lat], axis=1), *moe_p)
            x_ctx = x_ctx + m_c[5] * f[:, :L]
            x_lat = x_lat + m_l[5] * f[:, L:]
    return rmsnorm(x_lat, final_norm)
```

```cpp
#include <hip/hip_runtime.h>
#include <cstdio>
#include <cstdint>

#ifndef ACCI
#define ACCI 1
#endif
#define QSC128 (0.088388347648318440f * 1.4426950408889634f)
#define QSC192 (0.072168783648703220f * 1.4426950408889634f)

#ifndef CV_DEEP_DRAIN
#define CV_DEEP_DRAIN 1
#endif
#ifndef MLA_NQR
#ifndef ATT_EARLY
#define ATT_EARLY 1
#endif
#define MLA_NQR 6
#endif
#ifndef MK_ONE_LAUNCH
#define MK_ONE_LAUNCH 1
#endif

#define LAS __attribute__((address_space(3)))
#define GAS __attribute__((address_space(1)))
typedef unsigned short bf16_t;
typedef short bf16x8 __attribute__((ext_vector_type(8)));
typedef short s16x4 __attribute__((ext_vector_type(4)));
typedef float f32x2 __attribute__((ext_vector_type(2)));
typedef float f32x4 __attribute__((ext_vector_type(4)));
typedef float f32x16 __attribute__((ext_vector_type(16)));
typedef unsigned u32x2 __attribute__((ext_vector_type(2)));
typedef unsigned u32x4 __attribute__((ext_vector_type(4)));
typedef GAS unsigned gu32;
typedef GAS float gf32;
typedef GAS bf16_t gbf;

constexpr int D = 2048, SEQ = 8192, CTX = 256, T = CTX + SEQ;
constexpr int NE = 64, TOPK = 8, DE = 512;
constexpr int NIN = 4160, NINP = 4352;
constexpr float EPS = 1e-6f;
constexpr int PMAX = T + T * TOPK + NE * 256;
constexpr int NEX = NE + 1;

constexpr size_t al256(size_t x) { return (x + 255) / 256 * 256; }
constexpr size_t WS_CTL = 0, CTL_ZERO_BYTES = 65536;
constexpr int CW_BAR = 0, CW_CNT = 4096, CW_CUR = 4096 + 128, CW_ARR = 4096 + 640;
constexpr size_t WS_MOD = 1u << 20;
constexpr size_t WS_PART = WS_MOD + al256(2 * 2 * 12288 * 4);
constexpr size_t WS_TABM = WS_PART + al256(2 * 8 * 2 * 12288 * 4);
constexpr size_t WS_TABG = WS_TABM + al256((size_t)T * 32 * 8);
constexpr size_t WS_RS = WS_TABG + al256((size_t)T * 64 * 8);
constexpr size_t WS_TOKE = WS_RS + al256((size_t)T * 4 * 4);
constexpr size_t WS_TOKW = WS_TOKE + al256((size_t)T * 8 * 4);
constexpr size_t WS_TOKS = WS_TOKW + al256((size_t)T * 8 * 4);
constexpr size_t WS_SLOTW = WS_TOKS + al256((size_t)T * 8 * 4);
constexpr size_t WS_SLOTT = WS_SLOTW + al256((size_t)PMAX * 4);
constexpr size_t WS_TILEE = WS_SLOTT + al256((size_t)PMAX * 4);
constexpr size_t WS_WRT = WS_TILEE + al256(2 * 1024 * 4);
constexpr size_t WS_WIN = WS_WRT + al256((size_t)2 * 2 * NE * D * 2);
constexpr size_t WS_WUQ = WS_WIN + al256((size_t)NINP * D * 2);
constexpr size_t WS_WUKV = WS_WUQ + al256((size_t)1536 * 512 * 2);
constexpr size_t WS_WOUT = WS_WUKV + al256((size_t)2048 * 512 * 2);
constexpr size_t WS_WQKV = WS_WOUT + al256((size_t)D * D * 2);
constexpr size_t WS_WO = WS_WQKV + al256((size_t)3072 * D * 2);
constexpr size_t GU_BYTES = (size_t)1024 * D * 2, DN_BYTES = (size_t)D * DE * 2;
constexpr size_t WS_GU = WS_WO + al256((size_t)D * D * 2);
constexpr size_t WS_DN = WS_GU + (size_t)2 * NEX * GU_BYTES;
constexpr size_t WS_X1 = WS_DN + (size_t)2 * NEX * DN_BYTES;
constexpr size_t WS_XS = WS_X1 + (size_t)T * D * 4;
constexpr size_t WS_QKV = WS_XS + (size_t)T * D * 2;
constexpr size_t WS_QM = WS_QKV + (size_t)T * NINP * 2;
constexpr size_t WS_KF = WS_QM + (size_t)T * 1536 * 2;
constexpr size_t WS_VM = WS_KF + (size_t)T * 1536 * 2;
constexpr size_t WS_AO = WS_VM + (size_t)T * 1024 * 2;
constexpr size_t WS_HB = WS_AO + (size_t)T * D * 2;
constexpr size_t WS_YS = WS_HB + (size_t)PMAX * DE * 2;
constexpr size_t WS_END = WS_YS + (size_t)PMAX * D;

constexpr int RING_OFF = 0, RING_BYTES = 139264, MISC_OFF = RING_BYTES, MISC_BYTES = 16384, LDS_BYTES = RING_BYTES + MISC_BYTES;

__device__ __forceinline__ float bf2f_lo(unsigned w) { return __uint_as_float(w << 16); }
__device__ __forceinline__ float bf2f_hi(unsigned w) { return __uint_as_float(w & 0xffff0000u); }
__device__ __forceinline__ unsigned f2bf(float f) { unsigned u = __float_as_uint(f); return (u + 0x7fffu + ((u >> 16) & 1u)) >> 16; }
__device__ __forceinline__ unsigned cvt_pk_bf16(float lo, float hi) { unsigned r; asm volatile("v_cvt_pk_bf16_f32 %0, %1, %2" : "=v"(r) : "v"(lo), "v"(hi)); return r; }
__device__ __forceinline__ unsigned pk2(float lo, float hi) { return cvt_pk_bf16(lo, hi); }
__device__ __forceinline__ void x1_ld8(const gbf* p, f32x4& a, f32x4& b) { const u32x4 w = *(const GAS u32x4*)p; a = (f32x4){bf2f_lo(w[0]), bf2f_hi(w[0]), bf2f_lo(w[1]), bf2f_hi(w[1])}; b = (f32x4){bf2f_lo(w[2]), bf2f_hi(w[2]), bf2f_lo(w[3]), bf2f_hi(w[3])}; }
__device__ __forceinline__ f32x4 x1_ld4(const gbf* p) { const u32x2 w = *(const GAS u32x2*)p; return (f32x4){bf2f_lo(w[0]), bf2f_hi(w[0]), bf2f_lo(w[1]), bf2f_hi(w[1])}; }
__device__ __forceinline__ void x1_st4(gbf* p, f32x4 v) { *(GAS u32x2*)p = (u32x2){pk2(v[0], v[1]), pk2(v[2], v[3])}; }
__device__ __forceinline__ float wave_sum(float v) {
#pragma unroll
    for (int o = 1; o < 64; o <<= 1) v += __shfl_xor(v, o);
    return v;
}
#define LDS_WAIT() asm volatile("s_waitcnt lgkmcnt(0)" ::: "memory")
#define VM_WAIT() asm volatile("s_waitcnt vmcnt(0)" ::: "memory")
#define RLX_AGENT __ATOMIC_RELAXED, __HIP_MEMORY_SCOPE_AGENT

namespace pg8 {
constexpr int BM = 256, BK = 64, HALF = 128, HTB = HALF * BK * 2, STAGE_BYTES = 8 * HTB, NXCD = 8, WGM = 8;
__host__ __device__ __forceinline__ int lds_byte(int r, int c) { const int st = (r >> 4) * 2 + (c >> 5), rr = r & 15, cc = c & 31, ob = rr * 64 + cc * 2; return st * 1024 + (ob ^ (((ob >> 9) & 1) << 5)); }
__host__ __device__ __forceinline__ void stage_rc(int b, int& R, int& C) { const int st = b / 1024, sb = b % 1024, swz = sb ^ (((sb >> 9) & 1) << 5); R = (st >> 1) * 16 + swz / 64; C = (st & 1) * 32 + (swz % 64) / 2; }
__host__ __device__ __forceinline__ int perm32(int rho) { const int n = rho >> 4, i = rho & 15; return 8 * (i >> 2) + 4 * n + (i & 3); }

struct Unit { int pm, pn; const GAS char* a; const GAS char* b; int half; };
struct Gemm { int lda, ldb, K; };

__device__ __forceinline__ bool tile_of(long L, int nM, int nN, int& pm, int& pn) {
    const int nwg = nM * nN; if (L >= nwg) return false;
    int wgid = (int)L; { const int q = nwg / NXCD, r = nwg % NXCD, xcd = wgid % NXCD, off = wgid / NXCD; wgid = (xcd < r ? xcd * (q + 1) : r * (q + 1) + (xcd - r) * q) + off; }
    const int nig = WGM * nN, gid = wgid / nig, fm = gid * WGM, gsz = (nM - fm) < WGM ? (nM - fm) : WGM;
    pm = fm + ((wgid % nig) % gsz); pn = (wgid % nig) / gsz; return true;
}
struct DenseOrder {
    static constexpr bool GATHER = false; const GAS int* rowtab;
    int nM, nN, G, c; const GAS char* A; const GAS char* B; size_t tA, tB;
    __device__ __forceinline__ bool next(int i, Unit& u) const { if (!tile_of((long)i * G + c, nM, nN, u.pm, u.pn)) return false; u.a = A + (size_t)u.pm * tA; u.b = B + (size_t)u.pn * tB; u.half = 0; return true; }
};
struct UpOrder {
    static constexpr bool GATHER = false; const GAS int* rowtab;
    int nM, G, c; const GAS char* Aq; const GAS char* Akv; const GAS char* Bq; const GAS char* Bkv; size_t tA, tB;
    __device__ __forceinline__ bool next(int i, Unit& u) const { long L = (long)i * G + c; const int nq = nM * 6;
        if (L < nq) { if (!tile_of(L, nM, 6, u.pm, u.pn)) return false; u.a = Aq + (size_t)u.pm * tA; u.b = Bq + (size_t)u.pn * tB; u.half = 0; return true; }
        L -= nq; if (!tile_of(L, nM, 8, u.pm, u.pn)) return false; u.a = Akv + (size_t)u.pm * tA; u.b = Bkv + (size_t)u.pn * tB; u.half = 1; return true; }
};
template <bool GATHER_>
struct GroupedOrder {
    static constexpr bool GATHER = GATHER_; const GAS int* rowtab;
    int nM, nN, G, c; const GAS char* A; const GAS char* B; size_t tA, tB, eB; const LAS int* te;
    __device__ __forceinline__ bool next(int i, Unit& u) const { if (!tile_of((long)i * G + c, nM, nN, u.pm, u.pn)) return false; u.a = A + (size_t)u.pm * tA; u.b = B + (size_t)te[u.pm] * eB + (size_t)u.pn * tB; u.half = 0; return true; }
};

struct EpiBf16RS {
    static constexpr bool PERM = true;
    gbf* O; int ldc; const gf32* rscale;
    __device__ __forceinline__ void operator()(const f32x4 (&acc)[2][2][4][2], const Unit& u, int wr, int wc, int fr, int fq) const {
        const int row0 = u.pm * BM + wr * 64 + fr, col0 = u.pn * BM + wc * 32 + 8 * fq;
#pragma unroll
        for (int ai = 0; ai < 2; ++ai)
#pragma unroll
            for (int m = 0; m < 4; ++m) { const int row = row0 + ai * HALF + m * 16; const float s = rscale ? rscale[row] : 1.f; gbf* rowp = O + (size_t)row * ldc + col0;
#pragma unroll
                for (int bj = 0; bj < 2; ++bj) { const f32x4 v0 = acc[ai][bj][m][0] * s, v1 = acc[ai][bj][m][1] * s;
                    u32x4 w; w.x = cvt_pk_bf16(v0[0], v0[1]); w.y = cvt_pk_bf16(v0[2], v0[3]); w.z = cvt_pk_bf16(v1[0], v1[1]); w.w = cvt_pk_bf16(v1[2], v1[3]);
                    *(GAS u32x4*)(rowp + bj * HALF) = w; } }
    }
};
constexpr float YS_SCALE = 16.f;
struct EpiFp8RS {
    static constexpr bool PERM = true;
    GAS unsigned char* O; const gf32* rscale;
    __device__ __forceinline__ void operator()(const f32x4 (&acc)[2][2][4][2], const Unit& u, int wr, int wc, int fr, int fq) const {
        const int row0 = u.pm * BM + wr * 64 + fr, col0 = u.pn * BM + wc * 64 + 16 * fq;
#pragma unroll
        for (int ai = 0; ai < 2; ++ai)
#pragma unroll
            for (int m = 0; m < 4; ++m) { const int row = row0 + ai * HALF + m * 16; const float s = YS_SCALE; u32x4 w;
#pragma unroll
                for (int bj = 0; bj < 2; ++bj)
#pragma unroll
                    for (int n = 0; n < 2; ++n) { f32x4 v = acc[ai][bj][m][n] * s;
#pragma unroll
                        for (int j = 0; j < 4; ++j) v[j] = __builtin_amdgcn_fmed3f(v[j], -448.f, 448.f);
                        int p = __builtin_amdgcn_cvt_pk_fp8_f32(v[0], v[1], 0, false); p = __builtin_amdgcn_cvt_pk_fp8_f32(v[2], v[3], p, true); w[bj * 2 + n] = (unsigned)p; }
                *(GAS u32x4*)(O + (size_t)row * D + col0) = w; }
    }
};
struct EpiQRope {
    static constexpr bool PERM = true;
    gbf* O; const gf32* rscale; const GAS f32x4* tab;
    __device__ __forceinline__ void operator()(const f32x4 (&acc)[2][2][4][2], const Unit& u, int wr, int wc, int fr, int fq) const {
        const int row0 = u.pm * BM + wr * 64 + fr, col0 = u.pn * BM + wc * 32 + 8 * fq;
#pragma unroll
        for (int ai = 0; ai < 2; ++ai)
#pragma unroll
            for (int m = 0; m < 4; ++m) { const int row = row0 + ai * HALF + m * 16; const f32x2 sq = *(const GAS f32x2*)(rscale + 4 * row); const float s = rsqrtf((sq[0] + sq[1]) * (1.f / 512.f) + EPS) * (ACCI ? QSC192 : 1.f); gbf* rowp = O + (size_t)row * 1536 + col0;
#pragma unroll
                for (int bj = 0; bj < 2; ++bj) { f32x4 v0 = acc[ai][bj][m][0] * s, v1 = acc[ai][bj][m][1] * s;
                    const int c = col0 + bj * HALF, j = c % 192;
                    if (j >= 128) { const int i0 = (j - 128) >> 1;
                        const f32x4 t0 = tab[(size_t)row * 16 + (i0 >> 1)], t1 = tab[(size_t)row * 16 + (i0 >> 1) + 1];
                        const f32x4 a = v0, b = v1;
                        v0[0] = a[0] * t0[0] - a[1] * t0[1]; v0[1] = a[0] * t0[1] + a[1] * t0[0]; v0[2] = a[2] * t0[2] - a[3] * t0[3]; v0[3] = a[2] * t0[3] + a[3] * t0[2];
                        v1[0] = b[0] * t1[0] - b[1] * t1[1]; v1[1] = b[0] * t1[1] + b[1] * t1[0]; v1[2] = b[2] * t1[2] - b[3] * t1[3]; v1[3] = b[2] * t1[3] + b[3] * t1[2]; }
                    u32x4 w; w.x = cvt_pk_bf16(v0[0], v0[1]); w.y = cvt_pk_bf16(v0[2], v0[3]); w.z = cvt_pk_bf16(v1[0], v1[1]); w.w = cvt_pk_bf16(v1[2], v1[3]);
                    *(GAS u32x4*)(rowp + bj * HALF) = w; } }
    }
};
struct EpiIn {
    static constexpr bool PERM = true;
    gbf* O; gf32* ssq; gbf* KF; const GAS f32x4* tab; LAS float* red;
    __device__ __forceinline__ void operator()(const f32x4 (&acc)[2][2][4][2], const Unit& u, int wr, int wc, int fr, int fq) const {
        const int row0 = u.pm * BM + wr * 64 + fr, col0 = u.pn * BM + wc * 32 + 8 * fq;
#pragma unroll
        for (int ai = 0; ai < 2; ++ai)
#pragma unroll
            for (int m = 0; m < 4; ++m) { gbf* rowp = O + (size_t)(row0 + ai * HALF + m * 16) * NINP + col0;
#pragma unroll
                for (int bj = 0; bj < 2; ++bj) { const f32x4 v0 = acc[ai][bj][m][0], v1 = acc[ai][bj][m][1];
                    u32x4 w; w.x = cvt_pk_bf16(v0[0], v0[1]); w.y = cvt_pk_bf16(v0[2], v0[3]); w.z = cvt_pk_bf16(v1[0], v1[1]); w.w = cvt_pk_bf16(v1[2], v1[3]);
                    *(GAS u32x4*)(rowp + bj * HALF) = w; } }
        if (u.pn >= 12 && u.pn < 16) {
#pragma unroll
            for (int ai = 0; ai < 2; ++ai)
#pragma unroll
                for (int m = 0; m < 4; ++m) { float ss = 0.f;
#pragma unroll
                    for (int bj = 0; bj < 2; ++bj)
#pragma unroll
                        for (int n = 0; n < 2; ++n) { const f32x4 a = acc[ai][bj][m][n]; ss += (a[0] * a[0] + a[1] * a[1]) + (a[2] * a[2] + a[3] * a[3]); }
                    ss += __shfl_xor(ss, 16); ss += __shfl_xor(ss, 32);
                    if (fq == 0) red[(ai * HALF + wr * 64 + m * 16 + fr) * 4 + wc] = ss; }
            asm volatile("s_waitcnt lgkmcnt(0)" ::: "memory"); __builtin_amdgcn_s_barrier(); asm volatile("" ::: "memory");
            if (wc == 0 && fq == 0) {
#pragma unroll
                for (int ai = 0; ai < 2; ++ai)
#pragma unroll
                    for (int m = 0; m < 4; ++m) { const int rl = ai * HALF + wr * 64 + m * 16 + fr; const f32x4 p = *(const LAS f32x4*)(red + rl * 4);
                        ssq[(size_t)(u.pm * BM + rl) * 4 + (u.pn - 12)] = (p[0] + p[1]) + (p[2] + p[3]); } }
        } else if (u.pn == 16 && wc < 2) {
            const int cih = wc * 32 + 8 * fq;
#pragma unroll
            for (int ai = 0; ai < 2; ++ai)
#pragma unroll
                for (int m = 0; m < 4; ++m) { const int row = row0 + ai * HALF + m * 16; const f32x4 a = acc[ai][0][m][0], b = acc[ai][0][m][1];
                    const f32x4 t0 = tab[(size_t)row * 16 + (cih >> 2)], t1 = tab[(size_t)row * 16 + (cih >> 2) + 1];
                    u32x4 w;
                    w.x = cvt_pk_bf16(a[0] * t0[0] - a[1] * t0[1], a[0] * t0[1] + a[1] * t0[0]); w.y = cvt_pk_bf16(a[2] * t0[2] - a[3] * t0[3], a[2] * t0[3] + a[3] * t0[2]);
                    w.z = cvt_pk_bf16(b[0] * t1[0] - b[1] * t1[1], b[0] * t1[1] + b[1] * t1[0]); w.w = cvt_pk_bf16(b[2] * t1[2] - b[3] * t1[3], b[2] * t1[3] + b[3] * t1[2]);
#pragma unroll
                    for (int h = 0; h < 8; ++h) *(GAS u32x4*)(KF + (size_t)row * 1536 + h * 192 + 128 + cih) = w; }
        }
    }
};
struct EpiQKNorm {
    static constexpr bool PERM = true;
    gbf* O; const gf32* qg; const gf32* kg; const GAS f32x4* tab; LAS float* red;
    __device__ __forceinline__ void operator()(const f32x4 (&acc)[2][2][4][2], const Unit& u, int wr, int wc, int fr, int fq) const {
        const int row0 = u.pm * BM + wr * 64 + fr, col0 = u.pn * BM + wc * 32 + 8 * fq;
        if (u.pn >= 10) {
#pragma unroll
            for (int ai = 0; ai < 2; ++ai)
#pragma unroll
                for (int m = 0; m < 4; ++m) { gbf* rowp = O + (size_t)(row0 + ai * HALF + m * 16) * 3072 + col0;
#pragma unroll
                    for (int bj = 0; bj < 2; ++bj) { const f32x4 v0 = acc[ai][bj][m][0], v1 = acc[ai][bj][m][1];
                        u32x4 w; w.x = cvt_pk_bf16(v0[0], v0[1]); w.y = cvt_pk_bf16(v0[2], v0[3]); w.z = cvt_pk_bf16(v1[0], v1[1]); w.w = cvt_pk_bf16(v1[2], v1[3]);
                        *(GAS u32x4*)(rowp + bj * HALF) = w; } }
            return; }
#pragma unroll
        for (int ai = 0; ai < 2; ++ai)
#pragma unroll
            for (int m = 0; m < 4; ++m)
#pragma unroll
                for (int bj = 0; bj < 2; ++bj) { const f32x4 a = acc[ai][bj][m][0], b = acc[ai][bj][m][1];
                    float ss = (a[0] * a[0] + a[1] * a[1]) + (a[2] * a[2] + a[3] * a[3]) + (b[0] * b[0] + b[1] * b[1]) + (b[2] * b[2] + b[3] * b[3]);
                    ss += __shfl_xor(ss, 16); ss += __shfl_xor(ss, 32);
                    if (fq == 0) red[((ai * HALF + wr * 64 + m * 16 + fr) * 2 + bj) * 4 + wc] = ss; }
        asm volatile("s_waitcnt lgkmcnt(0)" ::: "memory"); __builtin_amdgcn_s_barrier(); asm volatile("" ::: "memory");
        const int cih = wc * 32 + 8 * fq;
        const gf32* g = (u.pn < 8 ? qg : kg) + cih;
        const f32x4 g0 = *(const GAS f32x4*)g, g1 = *(const GAS f32x4*)(g + 4);
#pragma unroll
        for (int ai = 0; ai < 2; ++ai)
#pragma unroll
            for (int m = 0; m < 4; ++m) { const int rl = ai * HALF + wr * 64 + m * 16 + fr, row = u.pm * BM + rl; gbf* rowp = O + (size_t)row * 3072 + col0;
                const f32x4 t0 = tab[(size_t)row * 32 + (cih >> 2)], t1 = tab[(size_t)row * 32 + (cih >> 2) + 1];
#pragma unroll
                for (int bj = 0; bj < 2; ++bj) { const f32x4 p = *(const LAS f32x4*)(red + (rl * 2 + bj) * 4);
                    const float rs = rsqrtf(((p[0] + p[1]) + (p[2] + p[3])) * (1.f / 128.f) + EPS) * ((ACCI && u.pn < 8) ? QSC128 : 1.f);
                    const f32x4 a = acc[ai][bj][m][0] * rs * g0, b = acc[ai][bj][m][1] * rs * g1;
                    u32x4 w;
                    w.x = cvt_pk_bf16(a[0] * t0[0] - a[1] * t0[1], a[0] * t0[1] + a[1] * t0[0]); w.y = cvt_pk_bf16(a[2] * t0[2] - a[3] * t0[3], a[2] * t0[3] + a[3] * t0[2]);
                    w.z = cvt_pk_bf16(b[0] * t1[0] - b[1] * t1[1], b[0] * t1[1] + b[1] * t1[0]); w.w = cvt_pk_bf16(b[2] * t1[2] - b[3] * t1[3], b[2] * t1[3] + b[3] * t1[2]);
                    *(GAS u32x4*)(rowp + bj * HALF) = w; } }
    }
};
struct EpiKV {
    static constexpr bool PERM = true;
    gbf* KF; gbf* VM; const gf32* rscale;
    __device__ __forceinline__ void operator()(const f32x4 (&acc)[2][2][4][2], const Unit& u, int wr, int wc, int fr, int fq) const {
        const int row0 = u.pm * BM + wr * 64 + fr, j0 = wc * 32 + 8 * fq;
#pragma unroll
        for (int ai = 0; ai < 2; ++ai)
#pragma unroll
            for (int m = 0; m < 4; ++m) { const int row = row0 + ai * HALF + m * 16; const f32x2 sq = *(const GAS f32x2*)(rscale + 4 * row + 2); const float s = rsqrtf((sq[0] + sq[1]) * (1.f / 512.f) + EPS);
#pragma unroll
                for (int bj = 0; bj < 2; ++bj) { const f32x4 v0 = acc[ai][bj][m][0] * s, v1 = acc[ai][bj][m][1] * s;
                    u32x4 w; w.x = cvt_pk_bf16(v0[0], v0[1]); w.y = cvt_pk_bf16(v0[2], v0[3]); w.z = cvt_pk_bf16(v1[0], v1[1]); w.w = cvt_pk_bf16(v1[2], v1[3]);
                    gbf* p = bj == 0 ? KF + (size_t)row * 1536 + u.pn * 192 + j0 : VM + (size_t)row * 1024 + u.pn * 128 + j0;
                    *(GAS u32x4*)p = w; } }
    }
};
template <bool XIN_BF>
struct EpiResid {
    static constexpr bool PERM = false;
    gf32* X1; const gf32* xin_ctx; const gf32* xin_lat; const gf32* gate_ctx; const gf32* gate_lat; int row_off;
    __device__ __forceinline__ void operator()(const f32x4 (&acc)[2][2][4][2], const Unit& u, int wr, int wc, int fr, int fq) const {
        const int row0 = u.pm * BM + wr * 64 + fr + row_off, col0 = u.pn * BM + wc * 32 + 4 * fq;
        const bool isctx = (u.pm * BM + row_off) < CTX;
        const gf32* gate = isctx ? gate_ctx : gate_lat; const gf32* xin = isctx ? xin_ctx : xin_lat;
        f32x4 gv[2][2];
#pragma unroll
        for (int bj = 0; bj < 2; ++bj)
#pragma unroll
            for (int n = 0; n < 2; ++n) gv[bj][n] = *(const GAS f32x4*)(gate + col0 + bj * HALF + n * 16);
#pragma unroll
        for (int ai = 0; ai < 2; ++ai)
#pragma unroll
            for (int m = 0; m < 4; ++m) { const size_t ro = (size_t)(row0 + ai * HALF + m * 16) * D + col0;
#pragma unroll
                for (int bj = 0; bj < 2; ++bj)
#pragma unroll
                    for (int n = 0; n < 2; ++n) { f32x4 xv; if constexpr (XIN_BF) xv = x1_ld4((const gbf*)xin + ro + bj * HALF + n * 16); else xv = *(const GAS f32x4*)(xin + ro + bj * HALF + n * 16);
                        x1_st4((gbf*)X1 + ro + bj * HALF + n * 16, xv + gv[bj][n] * acc[ai][bj][m][n]); } }
    }
};
struct EpiSwiGLU {
    static constexpr bool PERM = true;
    gbf* H; const gf32* rscale;
    __device__ __forceinline__ void operator()(const f32x4 (&acc)[2][2][4][2], const Unit& u, int wr, int wc, int fr, int fq) const {
        const int row0 = u.pm * BM + wr * 64 + fr, col0 = u.pn * 128 + wc * 32 + 8 * fq;
#pragma unroll
        for (int ai = 0; ai < 2; ++ai)
#pragma unroll
            for (int m = 0; m < 4; ++m) { const int row = row0 + ai * HALF + m * 16; float h[8]; const float rs = rscale[row];
#pragma unroll
                for (int n = 0; n < 2; ++n)
#pragma unroll
                    for (int j = 0; j < 4; ++j) { const float g = acc[ai][0][m][n][j], up = acc[ai][1][m][n][j]; h[n * 4 + j] = g * __builtin_amdgcn_rcpf(1.f + __expf(-g)) * (up * rs); }
                u32x4 w; w.x = cvt_pk_bf16(h[0], h[1]); w.y = cvt_pk_bf16(h[2], h[3]); w.z = cvt_pk_bf16(h[4], h[5]); w.w = cvt_pk_bf16(h[6], h[7]);
                *(GAS u32x4*)(H + (size_t)row * DE + col0) = w; }
    }
};

struct EpiUp {
    static constexpr bool PERM = true; EpiQRope q; EpiKV kv;
    __device__ __forceinline__ void operator()(const f32x4 (&acc)[2][2][4][2], const Unit& u, int wr, int wc, int fr, int fq) const { if (u.half == 0) q(acc, u, wr, wc, fr, fq); else kv(acc, u, wr, wc, fr, fq); }
};
template <class Epi, class Sched>
__device__ __forceinline__ void gemm_phase(LAS unsigned char* lds, const Gemm g, const Sched& S, const Epi& E) {
    int tid_ = threadIdx.x; asm volatile("" : "+v"(tid_));
    const int tid = tid_, wid = __builtin_amdgcn_readfirstlane(tid >> 6), lane = tid & 63, wr = wid >> 2, wc = wid & 3, fr = lane & 15, fq = lane >> 4;
    const int K = g.K, nt = K / BK;
    unsigned voA[2][2], nvoA[2][2], voffB[2]; int RA[2], CA[2];
#pragma unroll
    for (int i = 0; i < 2; ++i) { int R, C; stage_rc(tid * 16 + i * 8192, R, C); const int Rb = Epi::PERM ? ((R & ~31) + perm32(R & 31)) : R; RA[i] = R; CA[i] = C;
        voA[0][i] = (unsigned)(R * g.lda + C) * 2u; voA[1][i] = (unsigned)((R + HALF) * g.lda + C) * 2u; voffB[i] = (unsigned)(Rb * g.ldb + C) * 2u; }
    const size_t kstep = (size_t)(BK * 2);
    const size_t hstepB = (size_t)HALF * g.ldb * 2;
    const unsigned ldsw = (unsigned)wid * 1024u;
    const int aoff = lds_byte(wr * 64 + fr, fq * 8), boff = lds_byte(wc * 32 + fr, fq * 8);
#define PG8_SA(b, h) (((b) * 2 + (h)) * HTB)
#define PG8_SB(b, h) ((4 + (b) * 2 + (h)) * HTB)
#define PG8_STAGE(bufoff, gbase, voff) do { _Pragma("unroll") for (int _i = 0; _i < 2; ++_i) \
        __builtin_amdgcn_global_load_lds((const GAS unsigned*)((gbase) + (voff)[_i]), (LAS unsigned*)(lds + (bufoff) + ldsw + _i * 8192), 16, 0, 0); } while (0)
#define PG8_GATHER(u, dst) do { _Pragma("unroll") for (int _h = 0; _h < 2; ++_h) _Pragma("unroll") for (int _i = 0; _i < 2; ++_i) \
        dst[_h][_i] = (unsigned)(S.rowtab[(u).pm * BM + _h * HALF + RA[_i]] * g.lda + CA[_i]) * 2u; } while (0)
#define PG8_LDA(dst, b, h) do { _Pragma("unroll") for (int m = 0; m < 4; ++m) _Pragma("unroll") for (int k = 0; k < 2; ++k) dst[m][k] = *(const LAS bf16x8*)(lds + PG8_SA(b, h) + aoff + m * 2048 + k * 1024); } while (0)
#define PG8_LDB(dst, b, h) do { _Pragma("unroll") for (int n = 0; n < 2; ++n) _Pragma("unroll") for (int k = 0; k < 2; ++k) dst[n][k] = *(const LAS bf16x8*)(lds + PG8_SB(b, h) + boff + n * 2048 + k * 1024); } while (0)
#define PG8_MMA(ai, bj, At, Bt) do { __builtin_amdgcn_s_setprio(1); _Pragma("unroll") for (int m = 0; m < 4; ++m) _Pragma("unroll") for (int n = 0; n < 2; ++n) _Pragma("unroll") for (int k = 0; k < 2; ++k) \
        acc[ai][bj][m][n] = __builtin_amdgcn_mfma_f32_16x16x32_bf16(Bt[n][k], At[m][k], acc[ai][bj][m][n], 0, 0, 0); __builtin_amdgcn_s_setprio(0); } while (0)
#define PG8_WAIT_V(n) asm volatile("s_waitcnt vmcnt(" #n ")" ::: "memory")
#define PG8_WAIT_L(n) asm volatile("s_waitcnt lgkmcnt(" #n ")" ::: "memory")
#define PG8_BAR __builtin_amdgcn_s_barrier()
#define PG8_SCHED __builtin_amdgcn_sched_barrier(0)
    Unit cur, nxt; int ui = 0;
    if (!S.next(0, cur)) return;
    f32x4 acc[2][2][4][2];
#pragma unroll
    for (int a = 0; a < 2; ++a)
#pragma unroll
        for (int b = 0; b < 2; ++b)
#pragma unroll
            for (int m = 0; m < 4; ++m)
#pragma unroll
                for (int n = 0; n < 2; ++n) acc[a][b][m][n] = (f32x4){0.f, 0.f, 0.f, 0.f};
    bf16x8 At[4][2], B0[2][2], B1[2][2];
    const GAS char* cA = cur.a; const GAS char* cB = cur.b;
    if constexpr (Sched::GATHER) PG8_GATHER(cur, voA);
    PG8_STAGE(PG8_SB(0, 0), cB, voffB); PG8_STAGE(PG8_SB(0, 1), cB + hstepB, voffB); PG8_STAGE(PG8_SA(0, 0), cA, voA[0]); PG8_STAGE(PG8_SA(0, 1), cA, voA[1]);
    if (wr == 1) PG8_BAR;
    PG8_WAIT_V(2); PG8_BAR;
    PG8_STAGE(PG8_SB(1, 0), cB + kstep, voffB); PG8_STAGE(PG8_SA(1, 0), cA + kstep, voA[0]); PG8_STAGE(PG8_SB(1, 1), cB + hstepB + kstep, voffB);
    PG8_WAIT_V(6); PG8_BAR;
    for (;;) {
        const bool has_next = S.next(ui + 1, nxt);
        const GAS char* nA = has_next ? nxt.a : cA; const GAS char* nB = has_next ? nxt.b : cB;
        if constexpr (Sched::GATHER) { if (has_next) PG8_GATHER(nxt, nvoA); else {
#pragma unroll
            for (int _h = 0; _h < 2; ++_h)
#pragma unroll
                for (int _i = 0; _i < 2; ++_i) nvoA[_h][_i] = voA[_h][_i]; } }
        for (int t = 0; t < nt; t += 2) {
            const bool last = (t == nt - 2);
            const GAS char* a1 = cA + (size_t)(t + 1) * kstep;
            const GAS char* a2 = last ? nA : cA + (size_t)(t + 2) * kstep; const GAS char* b2 = last ? nB : cB + (size_t)(t + 2) * kstep;
            const GAS char* a3 = a2 + kstep; const GAS char* b3 = b2 + kstep;
            unsigned vo2[2][2];
#pragma unroll
            for (int _h = 0; _h < 2; ++_h)
#pragma unroll
                for (int _i = 0; _i < 2; ++_i) vo2[_h][_i] = (Sched::GATHER && last) ? nvoA[_h][_i] : voA[_h][_i];
            PG8_LDB(B0, 0, 0); PG8_LDB(B1, 0, 1); PG8_SCHED; PG8_LDA(At, 0, 0); PG8_STAGE(PG8_SA(1, 1), a1, voA[1]);
            PG8_WAIT_V(8); PG8_WAIT_L(0); PG8_BAR; PG8_MMA(0, 0, At, B0); PG8_MMA(0, 1, At, B1); PG8_BAR; PG8_SCHED;
            PG8_LDA(At, 0, 1); PG8_STAGE(PG8_SB(0, 0), b2, voffB); PG8_STAGE(PG8_SB(0, 1), b2 + hstepB, voffB); PG8_STAGE(PG8_SA(0, 0), a2, vo2[0]);
            PG8_WAIT_V(8); PG8_WAIT_L(0); PG8_BAR; PG8_MMA(1, 0, At, B0); PG8_MMA(1, 1, At, B1); PG8_BAR; PG8_SCHED;
            PG8_LDB(B0, 1, 0); PG8_LDB(B1, 1, 1); PG8_SCHED; PG8_LDA(At, 1, 0); PG8_STAGE(PG8_SA(0, 1), a2, vo2[1]);
            PG8_WAIT_V(8); PG8_WAIT_L(0); PG8_BAR; PG8_MMA(0, 0, At, B0); PG8_MMA(0, 1, At, B1); PG8_BAR; PG8_SCHED;
            PG8_LDA(At, 1, 1); PG8_STAGE(PG8_SB(1, 0), b3, voffB); PG8_STAGE(PG8_SB(1, 1), b3 + hstepB, voffB); PG8_STAGE(PG8_SA(1, 0), a3, vo2[0]);
            PG8_WAIT_V(8); PG8_WAIT_L(0); PG8_BAR; PG8_MMA(1, 0, At, B0); PG8_MMA(1, 1, At, B1); PG8_BAR; PG8_SCHED;
        }
        if (wr == 0) PG8_BAR;
        E(acc, cur, wr, wc, fr, fq);
        if (!has_next) break;
#pragma unroll
        for (int a = 0; a < 2; ++a)
#pragma unroll
            for (int b = 0; b < 2; ++b)
#pragma unroll
                for (int m = 0; m < 4; ++m)
#pragma unroll
                    for (int n = 0; n < 2; ++n) acc[a][b][m][n] = (f32x4){0.f, 0.f, 0.f, 0.f};
        cur = nxt; cA = nA; cB = nB; ++ui;
        if constexpr (Sched::GATHER) {
#pragma unroll
            for (int _h = 0; _h < 2; ++_h)
#pragma unroll
                for (int _i = 0; _i < 2; ++_i) voA[_h][_i] = nvoA[_h][_i]; }
        if (wr == 1) PG8_BAR;
    }
    PG8_WAIT_V(0);
    PG8_BAR;
#undef PG8_SA
#undef PG8_SB
#undef PG8_STAGE
#undef PG8_GATHER
#undef PG8_LDA
#undef PG8_LDB
#undef PG8_MMA
#undef PG8_WAIT_V
#undef PG8_WAIT_L
#undef PG8_BAR
#undef PG8_SCHED
}
}

namespace att {
constexpr int NW = 8, QBLK = 32, KVBLK = 64;
constexpr float THR = 8.f;
#define SBAR() __builtin_amdgcn_sched_barrier(0)
__device__ __forceinline__ int crow(int r, int hi) { return (r & 3) + 8 * (r >> 2) + 4 * hi; }
__device__ __forceinline__ unsigned cvtpk(float lo, float hi) { unsigned r; asm volatile("v_cvt_pk_bf16_f32 %0, %1, %2" : "=v"(r) : "v"(lo), "v"(hi)); return r; }
#ifndef PP_PRIO
#define PP_PRIO 1
#endif
#ifndef PP_VIS
#define PP_VIS 1
#endif
#ifndef VLD_IN_M
#define VLD_IN_M 1
#endif
#ifndef KLD_IN_M
#define KLD_IN_M 1
#endif
#ifndef MSTG_STEP
#define MSTG_STEP 1
#endif
#ifndef PP_ILV
#define PP_ILV 1
#endif
#ifndef PP_GHW
#define PP_GHW 1
#endif
#ifndef KROW192
#define KROW192 400
#endif
#ifndef KSWZ_MASK
#define KSWZ_MASK 15
#endif
template <int DK> __device__ __forceinline__ int kswz(int byte_off, int row) { if constexpr (DK == 128) return byte_off ^ ((row & KSWZ_MASK) << 4); else return KROW192 == 384 ? (byte_off ^ ((row & 7) << 4)) : byte_off; }
template <int DK> struct Cfg {
    static constexpr float SCALE = DK == 128 ? 0.088388347648318440f : 0.072168783648703220f;
    static constexpr int KROW = DK == 128 ? 256 : KROW192, SHM_V = KVBLK * 128 * 2, SHM_K = KVBLK * KROW, OFF_K = 2 * SHM_V, OFF_WS = OFF_K + 2 * SHM_K, BYTES = OFF_WS + NW * 64 * 4;
};
static_assert(Cfg<192>::BYTES <= 86016 && Cfg<128>::BYTES <= 86016, "parked-Q slots start at 86016");
template <int DK>
__device__ __forceinline__ void partialSM(f32x16& p0, f32x16& p1, float& m_reg, float& mn, float& alpha) {
    constexpr float SC = Cfg<DK>::SCALE, C = SC * 1.4426950408889634f;
    float pmax = p0[0];
#pragma unroll
    for (int r = 1; r < 16; ++r) pmax = fmaxf(pmax, p0[r]);
#pragma unroll
    for (int r = 0; r < 16; ++r) pmax = fmaxf(pmax, p1[r]);
    { auto rr = __builtin_amdgcn_permlane32_swap(__float_as_uint(pmax), __float_as_uint(pmax), false, false);
      pmax = fmaxf(__uint_as_float(rr[0]), __uint_as_float(rr[1])); }
    if (__builtin_expect(__all(pmax - m_reg <= THR / SC), 1)) { mn = m_reg; alpha = 1.f; }
    else { mn = fmaxf(m_reg, pmax); alpha = __builtin_amdgcn_exp2f((m_reg - mn) * C); m_reg = mn; }
    const float mnC = -mn * C;
#pragma unroll
    for (int r = 0; r < 16; ++r) p0[r] = fmaf(p0[r], C, mnC);
#pragma unroll
    for (int r = 0; r < 16; ++r) p1[r] = fmaf(p1[r], C, mnC);
#pragma unroll
    for (int r = 0; r < 16; ++r) p0[r] = __builtin_amdgcn_exp2f(p0[r]);
}
constexpr float THR2 = THR * 1.4426950408889634f;
__device__ __forceinline__ void partialSM3(f32x16& p0, f32x16& p1, float& m_run, float& alpha, unsigned& mpk, bool force) {
    float pmax = p0[0];
#pragma unroll
    for (int r = 1; r < 16; ++r) pmax = fmaxf(pmax, p0[r]);
#pragma unroll
    for (int r = 0; r < 16; ++r) pmax = fmaxf(pmax, p1[r]);
    { auto rr = __builtin_amdgcn_permlane32_swap(__float_as_uint(pmax), __float_as_uint(pmax), false, false);
      pmax = fmaxf(__uint_as_float(rr[0]), __uint_as_float(rr[1])); }
    if (__builtin_expect(!force && __all(pmax <= THR2), 1)) { alpha = 1.f; }
    else { const float d = force ? pmax : fmaxf(pmax, 0.f), mn = m_run + d;
        const unsigned hb = cvtpk(mn, 0.f) & 0xffffu; const float hf = __uint_as_float(hb << 16);
        const unsigned lb = cvtpk(mn - hf, 0.f) & 0xffffu; const float lf = __uint_as_float(lb << 16);
        const float mq = hf + lf, de = mq - m_run;
        alpha = force ? 1.f : __builtin_amdgcn_exp2f(-de); m_run = mq; mpk = (hb ^ 0x8000u) | ((lb ^ 0x8000u) << 16);
#pragma unroll
        for (int r = 0; r < 16; ++r) { p0[r] -= de; p1[r] -= de; } }
#pragma unroll
    for (int r = 0; r < 16; ++r) p0[r] = __builtin_amdgcn_exp2f(p0[r]);
}
__device__ __forceinline__ void finishSM(f32x16& p0, f32x16& p1, float alpha, float& l_reg, bf16x8& pa0, bf16x8& pa1, bf16x8& pa2, bf16x8& pa3) {
#pragma unroll
    for (int r = 0; r < 16; ++r) p1[r] = __builtin_amdgcn_exp2f(p1[r]);
    float ps = 0;
#pragma unroll
    for (int r = 0; r < 16; ++r) ps += p0[r];
#pragma unroll
    for (int r = 0; r < 16; ++r) ps += p1[r];
    { auto rr = __builtin_amdgcn_permlane32_swap(__float_as_uint(ps), __float_as_uint(ps), false, false);
      ps = __uint_as_float(rr[0]) + __uint_as_float(rr[1]); }
    l_reg = l_reg * alpha + ps;
#define PK4(P, BASE, OUT) do { unsigned a0 = cvtpk(P[BASE + 0], P[BASE + 1]), a1 = cvtpk(P[BASE + 2], P[BASE + 3]);   \
    unsigned b0 = cvtpk(P[BASE + 4], P[BASE + 5]), b1 = cvtpk(P[BASE + 6], P[BASE + 7]);                              \
    auto r0 = __builtin_amdgcn_permlane32_swap(a0, b0, false, false); auto r1 = __builtin_amdgcn_permlane32_swap(a1, b1, false, false); \
    u32x4 w = {r0[0], r1[0], r0[1], r1[1]}; OUT = *reinterpret_cast<bf16x8*>(&w); } while (0)
    PK4(p0, 0, pa0); PK4(p0, 8, pa1); PK4(p1, 0, pa2); PK4(p1, 8, pa3);
#undef PK4
}
template <int DK, int NQR>
__device__ __forceinline__ void qkt(f32x16& p0, f32x16& p1, const LAS char* Ks, const bf16x8* qr, const LAS char* qx, int r32, int hi) {
    constexpr int KROW = Cfg<DK>::KROW;
    p0 = f32x16{}; p1 = f32x16{};
#pragma unroll
    for (int d0 = 0; d0 < DK / 16; ++d0) { const int cb = (d0 * 16 + hi * 8) * 2, sw = kswz<DK>(cb, r32);
        const bf16x8 b0 = *reinterpret_cast<const LAS bf16x8*>(Ks + r32 * KROW + sw);
        const bf16x8 b1 = *reinterpret_cast<const LAS bf16x8*>(Ks + (32 + r32) * KROW + sw);
        bf16x8 q;
        if constexpr (true) { if (d0 < NQR) q = qr[d0]; else q = *reinterpret_cast<const LAS bf16x8*>(qx + ((2 * (d0 - NQR) + hi) << 4)); }
        p0 = __builtin_amdgcn_mfma_f32_32x32x16_bf16(b0, q, p0, 0, 0, 0);
        p1 = __builtin_amdgcn_mfma_f32_32x32x16_bf16(b1, q, p1, 0, 0, 0); }
}
#ifndef QLA
#define QLA 2
#endif
template <int DK, int NQR, int LA>
__device__ __forceinline__ void qkt_pipe(f32x16& p0, f32x16& p1, const LAS char* Ks, const bf16x8* qr, const LAS char* qx, int r32, int hi) {
    constexpr int KROW = Cfg<DK>::KROW, ND = DK / 16;
    bf16x8 b0[ND], b1[ND], qp[ND - NQR + 1];
    p0 = f32x16{}; p1 = f32x16{};
#define QLD(d) do { const int cb_ = ((d) * 16 + hi * 8) * 2, sw_ = kswz<DK>(cb_, r32);                                          \
    b0[d] = *reinterpret_cast<const LAS bf16x8*>(Ks + r32 * KROW + sw_); b1[d] = *reinterpret_cast<const LAS bf16x8*>(Ks + (32 + r32) * KROW + sw_);        \
    if ((d) >= NQR) qp[(d) >= NQR ? (d) - NQR : 0] = *reinterpret_cast<const LAS bf16x8*>(qx + ((2 * ((d) - NQR) + hi) << 4)); } while (0)
#pragma unroll
    for (int d0 = 0; d0 < LA; ++d0) QLD(d0);
    SBAR();
#pragma unroll
    for (int d0 = 0; d0 < ND; ++d0) {
        if (d0 + LA < ND) QLD(d0 + LA < ND ? d0 + LA : 0);
        bf16x8 q;
        if (d0 < NQR) q = qr[d0 < NQR ? d0 : 0]; else q = qp[d0 >= NQR ? d0 - NQR : 0];
        SBAR();
        p0 = __builtin_amdgcn_mfma_f32_32x32x16_bf16(b0[d0], q, p0, 0, 0, 0);
        p1 = __builtin_amdgcn_mfma_f32_32x32x16_bf16(b1[d0], q, p1, 0, 0, 0);
        SBAR();
    }
#undef QLD
}
__device__ __forceinline__ int v_st(int k, int c) { const int kk = (k & ~0xC) | ((k & 4) << 1) | ((k & 8) >> 1); return ((kk >> 3) * 4 + (c >> 5)) * 512 + ((kk & 7) * 32 + (c & 31)) * 2; }
__device__ __forceinline__ int v_rd_base(int lane) { return ((lane & 3) << 3) | (((lane >> 2) & 3) << 6) | (((lane >> 4) & 1) << 5) | (((lane >> 5) & 1) << 8); }
constexpr int v_rd_off(int d0, int ks, int half) { return d0 * 512 + ks * 4096 + half * 2048; }
template <int OFF> __device__ __forceinline__ s16x4 tr_read(int vb) {
    s16x4 r; asm volatile("ds_read_b64_tr_b16 %0, %1 offset:%2" : "=&v"(r) : "v"(vb), "i"(OFF) : "memory"); return r;
}
template <int D0> __device__ __forceinline__ void pv_one(f32x16& od, int vb, bf16x8 pa0, bf16x8 pa1, bf16x8 pa2, bf16x8 pa3) {
    const s16x4 l0 = tr_read<v_rd_off(D0, 0, 0)>(vb), h0 = tr_read<v_rd_off(D0, 0, 1)>(vb), l1 = tr_read<v_rd_off(D0, 1, 0)>(vb), h1 = tr_read<v_rd_off(D0, 1, 1)>(vb);
    const s16x4 l2 = tr_read<v_rd_off(D0, 2, 0)>(vb), h2 = tr_read<v_rd_off(D0, 2, 1)>(vb), l3 = tr_read<v_rd_off(D0, 3, 0)>(vb), h3 = tr_read<v_rd_off(D0, 3, 1)>(vb);
    asm volatile("s_waitcnt lgkmcnt(0)" ::: "memory"); SBAR();
#define PK(L, H) (bf16x8){L[0], L[1], L[2], L[3], H[0], H[1], H[2], H[3]}
    od = __builtin_amdgcn_mfma_f32_32x32x16_bf16(pa0, PK(l0, h0), od, 0, 0, 0);
    od = __builtin_amdgcn_mfma_f32_32x32x16_bf16(pa1, PK(l1, h1), od, 0, 0, 0);
    od = __builtin_amdgcn_mfma_f32_32x32x16_bf16(pa2, PK(l2, h2), od, 0, 0, 0);
    od = __builtin_amdgcn_mfma_f32_32x32x16_bf16(pa3, PK(l3, h3), od, 0, 0, 0);
#undef PK
}
__device__ __forceinline__ void pv_d0(f32x16* o, int vb, bf16x8 pa0, bf16x8 pa1, bf16x8 pa2, bf16x8 pa3) {
    pv_one<0>(o[0], vb, pa0, pa1, pa2, pa3); pv_one<1>(o[1], vb, pa0, pa1, pa2, pa3); pv_one<2>(o[2], vb, pa0, pa1, pa2, pa3); pv_one<3>(o[3], vb, pa0, pa1, pa2, pa3);
}
struct VFr { s16x4 f[8]; };
template <int D0> __device__ __forceinline__ void v_req(VFr& g, int vb) {
    g.f[0] = tr_read<v_rd_off(D0, 0, 0)>(vb); g.f[1] = tr_read<v_rd_off(D0, 0, 1)>(vb); g.f[2] = tr_read<v_rd_off(D0, 1, 0)>(vb); g.f[3] = tr_read<v_rd_off(D0, 1, 1)>(vb);
    g.f[4] = tr_read<v_rd_off(D0, 2, 0)>(vb); g.f[5] = tr_read<v_rd_off(D0, 2, 1)>(vb); g.f[6] = tr_read<v_rd_off(D0, 3, 0)>(vb); g.f[7] = tr_read<v_rd_off(D0, 3, 1)>(vb);
}
__device__ __forceinline__ void pv_mm(f32x16& od, const VFr& g, bf16x8 pa0, bf16x8 pa1, bf16x8 pa2, bf16x8 pa3) {
#define PK(L, H) (bf16x8){L[0], L[1], L[2], L[3], H[0], H[1], H[2], H[3]}
    od = __builtin_amdgcn_mfma_f32_32x32x16_bf16(pa0, PK(g.f[0], g.f[1]), od, 0, 0, 0);
    od = __builtin_amdgcn_mfma_f32_32x32x16_bf16(pa1, PK(g.f[2], g.f[3]), od, 0, 0, 0);
    od = __builtin_amdgcn_mfma_f32_32x32x16_bf16(pa2, PK(g.f[4], g.f[5]), od, 0, 0, 0);
    od = __builtin_amdgcn_mfma_f32_32x32x16_bf16(pa3, PK(g.f[6], g.f[7]), od, 0, 0, 0);
#undef PK
}
__device__ __forceinline__ void pv_rest(f32x16* o, VFr& ga, VFr& gb, int vb, bf16x8 pa0, bf16x8 pa1, bf16x8 pa2, bf16x8 pa3) {
    SBAR(); asm volatile("s_waitcnt lgkmcnt(0)" ::: "memory"); SBAR();
    pv_mm(o[0], ga, pa0, pa1, pa2, pa3); SBAR(); v_req<2>(ga, vb); SBAR();
    pv_mm(o[1], gb, pa0, pa1, pa2, pa3); SBAR(); v_req<3>(gb, vb); asm volatile("s_waitcnt lgkmcnt(8)" ::: "memory"); SBAR();
    pv_mm(o[2], ga, pa0, pa1, pa2, pa3); SBAR(); asm volatile("s_waitcnt lgkmcnt(0)" ::: "memory"); SBAR();
    pv_mm(o[3], gb, pa0, pa1, pa2, pa3);
}
template <int OFF> __device__ __forceinline__ s16x4 tr_readv(int vb) { return __builtin_amdgcn_ds_read_tr16_b64_v4i16((LAS s16x4*)(unsigned)(vb + OFF)); }
template <int D0> __device__ __forceinline__ void v_reqv(VFr& g, int vb) {
    g.f[0] = tr_readv<v_rd_off(D0, 0, 0)>(vb); g.f[1] = tr_readv<v_rd_off(D0, 0, 1)>(vb); g.f[2] = tr_readv<v_rd_off(D0, 1, 0)>(vb); g.f[3] = tr_readv<v_rd_off(D0, 1, 1)>(vb);
    g.f[4] = tr_readv<v_rd_off(D0, 2, 0)>(vb); g.f[5] = tr_readv<v_rd_off(D0, 2, 1)>(vb); g.f[6] = tr_readv<v_rd_off(D0, 3, 0)>(vb); g.f[7] = tr_readv<v_rd_off(D0, 3, 1)>(vb);
}
__device__ __forceinline__ void pv_rest2(f32x16* o, VFr& ga, VFr& gb, int vb, bf16x8 pa0, bf16x8 pa1, bf16x8 pa2, bf16x8 pa3) {
    SBAR(); pv_mm(o[0], ga, pa0, pa1, pa2, pa3); SBAR(); v_reqv<2>(ga, vb); SBAR();
    pv_mm(o[1], gb, pa0, pa1, pa2, pa3); SBAR(); v_reqv<3>(gb, vb); SBAR();
    pv_mm(o[2], ga, pa0, pa1, pa2, pa3); SBAR();
    pv_mm(o[3], gb, pa0, pa1, pa2, pa3);
}
template <int DK, int NQR, int LA>
__device__ __forceinline__ void qkt_pipe2(f32x16& p0, f32x16& p1, const LAS char* Ks, const bf16x8* qr, const LAS char* qx, int r32, int hi, VFr& ga, VFr& gb, int vb) {
    constexpr int KROW = Cfg<DK>::KROW, ND = DK / 16;
    bf16x8 b0[ND], b1[ND], qp[ND - NQR + 1];
    p0 = f32x16{}; p1 = f32x16{};
#define QLD(d) do { const int cb_ = ((d) * 16 + hi * 8) * 2, sw_ = kswz<DK>(cb_, r32);                                          \
    b0[d] = *reinterpret_cast<const LAS bf16x8*>(Ks + r32 * KROW + sw_); b1[d] = *reinterpret_cast<const LAS bf16x8*>(Ks + (32 + r32) * KROW + sw_);        \
    if ((d) >= NQR) qp[(d) >= NQR ? (d) - NQR : 0] = *reinterpret_cast<const LAS bf16x8*>(qx + ((2 * ((d) - NQR) + hi) << 4)); } while (0)
#pragma unroll
    for (int d0 = 0; d0 < LA; ++d0) QLD(d0);
    SBAR(); v_reqv<0>(ga, vb); SBAR();
#pragma unroll
    for (int d0 = 0; d0 < ND; ++d0) {
        if (d0 + LA < ND) QLD(d0 + LA < ND ? d0 + LA : 0);
        if (d0 == ND / 2 - 1) { SBAR(); v_reqv<1>(gb, vb); }
        bf16x8 q;
        if (d0 < NQR) q = qr[d0 < NQR ? d0 : 0]; else q = qp[d0 >= NQR ? d0 - NQR : 0];
        SBAR();
        p0 = __builtin_amdgcn_mfma_f32_32x32x16_bf16(b0[d0], q, p0, 0, 0, 0);
        p1 = __builtin_amdgcn_mfma_f32_32x32x16_bf16(b1[d0], q, p1, 0, 0, 0);
        SBAR();
    }
#undef QLD
}
__device__ __forceinline__ s16x4 tr_rd(int vb, int off) { return __builtin_amdgcn_ds_read_tr16_b64_v4i16((LAS s16x4*)(unsigned)(vb + off)); }
template <int ND> __device__ __forceinline__ constexpr int pair_of(int s) { return ND == 8 ? s : ((s % 3 != 2) ? (s / 3) * 2 + (s % 3) : -1); }
template <int DK, int NQR, int LA, class Mid>
__device__ __forceinline__ void m_seg(f32x16& p0, f32x16& p1, f32x16* o, const LAS char* Ks, const bf16x8* qr, const LAS char* qx, int r32, int hi, int vb, bf16x8 pa0, bf16x8 pa1, bf16x8 pa2, bf16x8 pa3, unsigned mpk, const Mid& mid) {
    constexpr int KROW = Cfg<DK>::KROW, ND = DK / 16;
    bf16x8 b0[ND], b1[ND], qp[ND - NQR + 1]; s16x4 vf[8][4];
    p0 = f32x16{}; p1 = f32x16{};
#define QLD(d) do { const int cb_ = ((d) * 16 + hi * 8) * 2, sw_ = kswz<DK>(cb_, r32);                                          \
    b0[d] = *reinterpret_cast<const LAS bf16x8*>(Ks + r32 * KROW + sw_); b1[d] = *reinterpret_cast<const LAS bf16x8*>(Ks + (32 + r32) * KROW + sw_);        \
    if ((d) >= NQR) qp[(d) >= NQR ? (d) - NQR : 0] = *reinterpret_cast<const LAS bf16x8*>(qx + ((2 * ((d) - NQR) + hi) << 4)); } while (0)
#define VLD(pp) do { const int d0_ = (pp) >> 1, kh_ = (pp) & 1;                                                                 \
    vf[pp][0] = tr_rd(vb, v_rd_off(d0_, 2 * kh_, 0)); vf[pp][1] = tr_rd(vb, v_rd_off(d0_, 2 * kh_, 1));                          \
    vf[pp][2] = tr_rd(vb, v_rd_off(d0_, 2 * kh_ + 1, 0)); vf[pp][3] = tr_rd(vb, v_rd_off(d0_, 2 * kh_ + 1, 1)); } while (0)
#define PK(L, H) (bf16x8){L[0], L[1], L[2], L[3], H[0], H[1], H[2], H[3]}
#pragma unroll
    for (int s = 0; s < LA; ++s) { QLD(s); if (pair_of<ND>(s) >= 0) VLD(pair_of<ND>(s) >= 0 ? pair_of<ND>(s) : 0); }
    SBAR();
    if (ACCI) {
        u32x4 one_ = {hi == 0 ? 0x3F803F80u : 0u, 0u, 0u, 0u}, qm_ = {hi == 0 ? mpk : 0u, 0u, 0u, 0u};
        p0 = __builtin_amdgcn_mfma_f32_32x32x16_bf16(*reinterpret_cast<bf16x8*>(&one_), *reinterpret_cast<bf16x8*>(&qm_), p0, 0, 0, 0);
        p1 = __builtin_amdgcn_mfma_f32_32x32x16_bf16(*reinterpret_cast<bf16x8*>(&one_), *reinterpret_cast<bf16x8*>(&qm_), p1, 0, 0, 0);
        SBAR(); }
#pragma unroll
    for (int s = 0; s < ND; ++s) {
        if (s + LA < ND) { QLD(s + LA < ND ? s + LA : 0); if (pair_of<ND>(s + LA) >= 0) VLD(pair_of<ND>(s + LA) >= 0 ? pair_of<ND>(s + LA) : 0); }
        bf16x8 q;
        if (s < NQR) q = qr[s < NQR ? s : 0]; else q = qp[s >= NQR ? s - NQR : 0];
        SBAR();
        p0 = __builtin_amdgcn_mfma_f32_32x32x16_bf16(b0[s], q, p0, 0, 0, 0);
        p1 = __builtin_amdgcn_mfma_f32_32x32x16_bf16(b1[s], q, p1, 0, 0, 0);
        if (pair_of<ND>(s) >= 0) { const int pp = pair_of<ND>(s) >= 0 ? pair_of<ND>(s) : 0; f32x16& od = o[pp >> 1];
            od = __builtin_amdgcn_mfma_f32_32x32x16_bf16((pp & 1) ? pa2 : pa0, PK(vf[pp][0], vf[pp][1]), od, 0, 0, 0);
            od = __builtin_amdgcn_mfma_f32_32x32x16_bf16((pp & 1) ? pa3 : pa1, PK(vf[pp][2], vf[pp][3]), od, 0, 0, 0); }
        SBAR();
        if (s == MSTG_STEP) { mid(); SBAR(); }
    }
#undef QLD
#undef VLD
#undef PK
}
__device__ __forceinline__ void store_o(const f32x16* o, const float* rli, LAS char* lds, gbf* Ob, int t, int hi) {
    const int w = t >> 6, lane = t & 63, r32 = lane & 31;
    LAS char* sl = lds + w * 8192;
#pragma unroll
    for (int r = 0; r < 16; r += 2) { const int row0 = crow(r, hi), row1 = crow(r + 1, hi);
#pragma unroll
        for (int d0 = 0; d0 < 4; ++d0) { const unsigned pk = cvtpk(o[d0][r] * rli[r], o[d0][r + 1] * rli[r + 1]);
            *(LAS unsigned short*)(sl + row0 * 256 + (d0 * 32 + r32) * 2) = (unsigned short)pk;
            *(LAS unsigned short*)(sl + row1 * 256 + (d0 * 32 + r32) * 2) = (unsigned short)(pk >> 16); } }
#pragma unroll
    for (int it = 0; it < 8; ++it) { const int q = it * 64 + lane, row = q >> 4, cc = q & 15;
        const bf16x8 v = *(const LAS bf16x8*)(sl + q * 16);
        *(GAS bf16x8*)(Ob + (size_t)(w * QBLK + row) * D + cc * 8) = v; }
}
struct DensePol {
    __device__ __forceinline__ bool active(int, int) const { return true; }
    __device__ __forceinline__ int tile_row(int j) const { return j * KVBLK; }
    __device__ __forceinline__ void hook(f32x16&, f32x16&, int, int, int, int) const {}
};
struct NaPol {
    int r_unit, rlo; const LAS float* rpb;
    __device__ __forceinline__ int tile_row(int j) const { return j < 4 ? j * KVBLK : CTX + (rlo + j - 4) * 64; }
    __device__ __forceinline__ bool active(int j, int wid) const {
        if (j < 4) return true; const int kr = rlo + j - 4, qrow = r_unit + (wid >> 1); int r0 = qrow - 4; r0 = r0 < 0 ? 0 : (r0 > 120 ? 120 : r0); return kr >= r0 && kr <= r0 + 7; }
    __device__ __forceinline__ void hook(f32x16& p0, f32x16& p1, int j, int wid, int r32, int hi) const {
        const bool loc = j >= 4;
        const int kr = rlo + j - 4, qrow = r_unit + (wid >> 1), qc = (wid & 1) * 32 + r32;
        int r0 = qrow - 4; r0 = r0 < 0 ? 0 : (r0 > 120 ? 120 : r0);
        int c0 = qc - 8; c0 = c0 < 0 ? 0 : (c0 > 48 ? 48 : c0);
        const bool row_ok = (kr >= r0) && (kr <= r0 + 7);
        const float fb = (loc && row_ok) ? 1.f : 0.f, fp = loc ? -1e29f : 0.f, rowpen = (loc && !row_ok) ? -1e30f : 0.f;
        const int rbase = (kr - qrow + 7) * 31 + 15 - qc;
#pragma unroll
        for (int r = 0; r < 16; ++r) { const int kc = crow(r, hi); const int d = kc - c0; int idx = rbase + kc; idx = idx < 0 ? 0 : (idx > 464 ? 464 : idx);
            p0[r] = (p0[r] + rowpen) + (fb * rpb[idx] + fp * fabsf((float)(d & ~15))); }
#pragma unroll
        for (int r = 0; r < 16; ++r) { const int kc = 32 + crow(r, hi); const int d = kc - c0; int idx = rbase + kc; idx = idx < 0 ? 0 : (idx > 464 ? 464 : idx);
            p1[r] = (p1[r] + rowpen) + (fb * rpb[idx] + fp * fabsf((float)(d & ~15))); }
    }
};
template <int DK, int LDQ, int LDK, int LDV, bool PIPE, int SDEPTH, int QLDS, class Pol>
__device__ __forceinline__ void attn_body(const gbf* Qb, const gbf* Kb, const gbf* Vb, gbf* Ob, int NT, LAS char* lds, const Pol& pol) {
    using C = Cfg<DK>; constexpr int ND = DK / 16, SHM_V = C::SHM_V, SHM_K = C::SHM_K, ldo = D;
    int tid_ = threadIdx.x; asm volatile("" : "+v"(tid_));
    const int tid = tid_, wid = __builtin_amdgcn_readfirstlane(tid >> 6), lane = tid & 63, r32 = lane & 31, hi = lane >> 5;
    LAS char* V_lds = lds; LAS char* K_lds = lds + C::OFF_K;
    LAS float* ws = (LAS float*)(lds + C::OFF_WS) + wid * 64; LAS float* li_l = ws; LAS float* al_l = ws + 32;
    constexpr int NQR = QLDS ? QLDS : ND;
    float m_reg = -1e30f, l_reg = 0; f32x16 o[4] = {}; bf16x8 qr[NQR];
    const gbf* Qw = Qb + (size_t)(wid * QBLK + r32) * LDQ + hi * 8;
    LAS char* qx = lds + 86016 + wid * (32 * 16 * 2 * (ND - NQR)) + r32 * (16 * 2 * (ND - NQR));
#pragma unroll
    for (int d0 = 0; d0 < ND; ++d0) { const bf16x8 q = *reinterpret_cast<const GAS bf16x8*>(Qw + d0 * 16);
        if (d0 < NQR) qr[d0 < NQR ? d0 : 0] = q; else *reinterpret_cast<LAS bf16x8*>(qx + ((2 * (d0 - NQR) + hi) << 4)) = q; }
    const int sr = tid >> 4, sc = (tid & 15) * 8, vst0 = v_st(sr, sc), vst1 = v_st(32 + sr, sc);
    const int kr_ = DK == 128 ? sr : (tid >> 3), kc_ = DK == 128 ? sc : (tid & 7) * 8;
    const int kst0 = DK == 128 ? sr * 256 + kswz<DK>(sc * 2, sr) : kr_ * C::KROW + kswz<DK>(kc_ * 2, kr_);
    const int kst1 = DK == 128 ? (32 + sr) * 256 + kswz<DK>(sc * 2, sr) : kr_ * C::KROW + kswz<DK>(kc_ * 2 + 128, kr_);
    const int kst2 = kr_ * C::KROW + kswz<DK>(kc_ * 2 + 256, kr_);
    const unsigned voffV = (unsigned)(sr * LDV + sc) * 2u, voffK = (unsigned)(kr_ * LDK + kc_) * 2u;
    const int vb0 = (int)(unsigned)(uintptr_t)V_lds + v_rd_base(lane);
    struct { bf16x8 vs0, vs1, ks0, ks1, ks2; } sr_[SDEPTH];
#define SLOAD(i, tile) do { const int _r0 = __builtin_amdgcn_readfirstlane(pol.tile_row(tile));                                                  \
    const GAS char* _vt = (const GAS char*)Vb + (size_t)_r0 * (LDV * 2); const GAS char* _kt = (const GAS char*)Kb + (size_t)_r0 * (LDK * 2);    \
    sr_[i].vs0 = *reinterpret_cast<const GAS bf16x8*>(_vt + voffV); sr_[i].vs1 = *reinterpret_cast<const GAS bf16x8*>(_vt + (size_t)(32 * LDV * 2) + voffV); \
    if constexpr (DK == 128) { sr_[i].ks0 = *reinterpret_cast<const GAS bf16x8*>(_kt + voffK); sr_[i].ks1 = *reinterpret_cast<const GAS bf16x8*>(_kt + (size_t)(32 * LDK * 2) + voffK); } \
    else { sr_[i].ks0 = *reinterpret_cast<const GAS bf16x8*>(_kt + voffK); sr_[i].ks1 = *reinterpret_cast<const GAS bf16x8*>(_kt + 128 + voffK); sr_[i].ks2 = *reinterpret_cast<const GAS bf16x8*>(_kt + 256 + voffK); } } while (0)
#define SWRITE(b, i) do { *(LAS bf16x8*)(V_lds + (b) * SHM_V + vst0) = sr_[i].vs0; *(LAS bf16x8*)(V_lds + (b) * SHM_V + vst1) = sr_[i].vs1;     \
    *(LAS bf16x8*)(K_lds + (b) * SHM_K + kst0) = sr_[i].ks0; *(LAS bf16x8*)(K_lds + (b) * SHM_K + kst1) = sr_[i].ks1;                            \
    if constexpr (DK == 192) *(LAS bf16x8*)(K_lds + (b) * SHM_K + kst2) = sr_[i].ks2; } while (0)
#define SWAIT() do { if constexpr (SDEPTH == 1) asm volatile("s_waitcnt vmcnt(0)" ::: "memory"); else if constexpr (DK == 128) asm volatile("s_waitcnt vmcnt(4)" ::: "memory"); else asm volatile("s_waitcnt vmcnt(5)" ::: "memory"); } while (0)
#define RESC(a) do { if (__any((a) < 1.f)) { if (hi == 0) al_l[r32] = (a); asm volatile("s_waitcnt lgkmcnt(0)" ::: "memory"); \
    _Pragma("unroll") for (int d = 0; d < 4; ++d) _Pragma("unroll") for (int r = 0; r < 16; ++r) o[d][r] *= al_l[crow(r, hi)]; } } while (0)
    bf16x8 pa0, pa1, pa2, pa3;
    if constexpr (PIPE && SDEPTH == 1 && ATT_EARLY) {
        f32x16 pA0, pA1, pB0, pB1; float mnA, mnB, alA, alB;
        SLOAD(0, 0); asm volatile("s_waitcnt vmcnt(0)" ::: "memory"); SWRITE(0, 0); SLOAD(0, 1); __syncthreads();
        qkt<DK, NQR>(pA0, pA1, K_lds, qr, qx, r32, hi); pol.hook(pA0, pA1, 0, wid, r32, hi); partialSM<DK>(pA0, pA1, m_reg, mnA, alA);
        asm volatile("s_waitcnt vmcnt(0)" ::: "memory"); SWRITE(1, 0); SLOAD(0, 2 < NT ? 2 : NT - 1); __syncthreads();
        for (int j = 1; j + 1 < NT; j += 2) {
            SBAR(); qkt<DK, NQR>(pB0, pB1, K_lds + SHM_K, qr, qx, r32, hi); pol.hook(pB0, pB1, j, wid, r32, hi);
            finishSM(pA0, pA1, alA, l_reg, pa0, pa1, pa2, pa3); SBAR();
            pv_d0(o, vb0, pa0, pa1, pa2, pa3); partialSM<DK>(pB0, pB1, m_reg, mnB, alB);
            __syncthreads(); asm volatile("s_waitcnt vmcnt(0)" ::: "memory"); SWRITE(0, 0); SLOAD(0, j + 2);
            RESC(alB); __syncthreads();
            SBAR(); qkt<DK, NQR>(pA0, pA1, K_lds, qr, qx, r32, hi); pol.hook(pA0, pA1, j + 1, wid, r32, hi);
            finishSM(pB0, pB1, alB, l_reg, pa0, pa1, pa2, pa3); SBAR();
            pv_d0(o, vb0 + SHM_V, pa0, pa1, pa2, pa3); partialSM<DK>(pA0, pA1, m_reg, mnA, alA);
            __syncthreads(); asm volatile("s_waitcnt vmcnt(0)" ::: "memory"); SWRITE(1, 0); SLOAD(0, j + 3 < NT ? j + 3 : NT - 1);
            RESC(alA); __syncthreads();
        }
        SBAR(); qkt<DK, NQR>(pB0, pB1, K_lds + SHM_K, qr, qx, r32, hi); pol.hook(pB0, pB1, NT - 1, wid, r32, hi);
        finishSM(pA0, pA1, alA, l_reg, pa0, pa1, pa2, pa3); SBAR();
        pv_d0(o, vb0, pa0, pa1, pa2, pa3); partialSM<DK>(pB0, pB1, m_reg, mnB, alB);
        __syncthreads(); RESC(alB);
        finishSM(pB0, pB1, alB, l_reg, pa0, pa1, pa2, pa3); SBAR();
        pv_d0(o, vb0 + SHM_V, pa0, pa1, pa2, pa3);
    } else if constexpr (PIPE) {
        f32x16 pA0, pA1, pB0, pB1; float mnA, mnB, alA, alB;
        constexpr int SE = 0, SO = SDEPTH - 1;
        SLOAD(SE, 0); asm volatile("s_waitcnt vmcnt(0)" ::: "memory"); SWRITE(0, SE); __syncthreads();
        qkt<DK, NQR>(pA0, pA1, K_lds, qr, qx, r32, hi); pol.hook(pA0, pA1, 0, wid, r32, hi); partialSM<DK>(pA0, pA1, m_reg, mnA, alA);
        SLOAD(SO, 1); if constexpr (SDEPTH == 2) { if (2 < NT) SLOAD(SE, 2); }
        SWAIT(); SWRITE(1, SO); __syncthreads();
        for (int j = 1; j + 1 < NT; j += 2) {
            SBAR(); qkt<DK, NQR>(pB0, pB1, K_lds + SHM_K, qr, qx, r32, hi); pol.hook(pB0, pB1, j, wid, r32, hi);
            finishSM(pA0, pA1, alA, l_reg, pa0, pa1, pa2, pa3); SBAR();
            SLOAD(SO, j + SDEPTH); SBAR();
            pv_d0(o, vb0, pa0, pa1, pa2, pa3); partialSM<DK>(pB0, pB1, m_reg, mnB, alB);
            __syncthreads(); SWAIT(); SWRITE(0, SE);
            RESC(alB); __syncthreads();
            SBAR(); qkt<DK, NQR>(pA0, pA1, K_lds, qr, qx, r32, hi); pol.hook(pA0, pA1, j + 1, wid, r32, hi);
            finishSM(pB0, pB1, alB, l_reg, pa0, pa1, pa2, pa3); SBAR();
            if (SDEPTH == 1 || j + 3 < NT) SLOAD(SE, j + 1 + SDEPTH); SBAR();
            pv_d0(o, vb0 + SHM_V, pa0, pa1, pa2, pa3); partialSM<DK>(pA0, pA1, m_reg, mnA, alA);
            __syncthreads(); SWAIT(); SWRITE(1, SO);
            RESC(alA); __syncthreads();
        }
        SBAR(); qkt<DK, NQR>(pB0, pB1, K_lds + SHM_K, qr, qx, r32, hi); pol.hook(pB0, pB1, NT - 1, wid, r32, hi);
        finishSM(pA0, pA1, alA, l_reg, pa0, pa1, pa2, pa3); SBAR();
        pv_d0(o, vb0, pa0, pa1, pa2, pa3); partialSM<DK>(pB0, pB1, m_reg, mnB, alB);
        __syncthreads(); RESC(alB);
        finishSM(pB0, pB1, alB, l_reg, pa0, pa1, pa2, pa3); SBAR();
        pv_d0(o, vb0 + SHM_V, pa0, pa1, pa2, pa3);
    } else {
        f32x16 p0, p1; float mn, al;
        SLOAD(0, 0); asm volatile("s_waitcnt vmcnt(0)" ::: "memory"); SWRITE(0, 0); __syncthreads();
        for (int j = 0; j < NT; ++j) {
            const int bsel = j & 1;
            if (j + 1 < NT) SLOAD(0, j + 1);
            const bool act = pol.active(j, wid);
            SBAR(); if (act) { qkt<DK, NQR>(p0, p1, K_lds + bsel * SHM_K, qr, qx, r32, hi); pol.hook(p0, p1, j, wid, r32, hi); }
            else {
#pragma unroll
                for (int r = 0; r < 16; ++r) { p0[r] = -1e30f; p1[r] = -1e30f; } }
            partialSM<DK>(p0, p1, m_reg, mn, al); RESC(al);
            finishSM(p0, p1, al, l_reg, pa0, pa1, pa2, pa3); SBAR();
            if (act) pv_d0(o, vb0 + bsel * SHM_V, pa0, pa1, pa2, pa3);
            if (j + 1 < NT) { asm volatile("s_waitcnt vmcnt(0)" ::: "memory"); SWRITE(bsel ^ 1, 0); }
            __syncthreads();
        }
    }
    __syncthreads();
    if (hi == 0) li_l[r32] = l_reg; asm volatile("s_waitcnt lgkmcnt(0)" ::: "memory");
    float rli[16];
#pragma unroll
    for (int r = 0; r < 16; ++r) rli[r] = __builtin_amdgcn_rcpf(li_l[crow(r, hi)]);
    int tid_o = threadIdx.x; asm volatile("" : "+v"(tid_o));
    store_o(o, rli, lds, Ob, tid_o, hi);
#undef SLOAD
#undef SWRITE
#undef SWAIT
#undef RESC
}

template <int DK, int LDQ, int LDK, int LDV, int QLDS, int LA, class Pol>
__device__ __forceinline__ void attn_pp(const gbf* Qb, const gbf* Kb, const gbf* Vb, gbf* Ob, int NT, LAS char* lds, const Pol& pol) {
    using C = Cfg<DK>; constexpr int ND = DK / 16, SHM_V = C::SHM_V, SHM_K = C::SHM_K, ldo = D;
    int tid_ = threadIdx.x; asm volatile("" : "+v"(tid_));
    const int tid = tid_, wid = __builtin_amdgcn_readfirstlane(tid >> 6), lane = tid & 63, r32 = lane & 31, hi = lane >> 5;
    LAS char* V_lds = lds; LAS char* K_lds = lds + C::OFF_K;
    LAS float* ws = (LAS float*)(lds + C::OFF_WS) + wid * 64; LAS float* li_l = ws; LAS float* al_l = ws + 32;
    int g;
    { const unsigned simd = (unsigned)__builtin_amdgcn_s_getreg((1 << 11) | (4 << 6) | 4);
      volatile LAS unsigned* sid = (volatile LAS unsigned*)(lds + C::OFF_WS);
      if (lane == 0) sid[wid * 64 + 32] = simd;
      __syncthreads();
      int cnt = 0;
#pragma unroll
      for (int w = 0; w < NW; ++w) cnt += (w < wid && sid[w * 64 + 32] == simd) ? 1 : 0;
      g = __builtin_amdgcn_readfirstlane(PP_GHW ? (cnt & 1) : (wid >> 2));
      __syncthreads(); }
    constexpr int NQR = QLDS ? QLDS : ND;
    float m_reg = ACCI ? 0.f : -1e30f, l_reg = 0; unsigned mpk = 0u;     f32x16 o[4] = {}; bf16x8 qr[NQR];
    const gbf* Qw = Qb + (size_t)(wid * QBLK + r32) * LDQ + hi * 8;
    LAS char* qx = lds + 86016 + wid * (32 * 16 * 2 * (ND - NQR)) + r32 * (16 * 2 * (ND - NQR));
#pragma unroll
    for (int d0 = 0; d0 < ND; ++d0) { const bf16x8 q = *reinterpret_cast<const GAS bf16x8*>(Qw + d0 * 16);
        if (d0 < NQR) qr[d0 < NQR ? d0 : 0] = q; else *reinterpret_cast<LAS bf16x8*>(qx + ((2 * (d0 - NQR) + hi) << 4)) = q; }
    const int sr = tid >> 4, sc = (tid & 15) * 8, vst0 = v_st(sr, sc), vst1 = v_st(32 + sr, sc);
    const int kr_ = DK == 128 ? sr : (tid >> 3), kc_ = DK == 128 ? sc : (tid & 7) * 8;
    const int kst0 = DK == 128 ? sr * 256 + kswz<DK>(sc * 2, sr) : kr_ * C::KROW + kswz<DK>(kc_ * 2, kr_);
    const int kst1 = DK == 128 ? (32 + sr) * 256 + kswz<DK>(sc * 2, sr) : kr_ * C::KROW + kswz<DK>(kc_ * 2 + 128, kr_);
    const int kst2 = kr_ * C::KROW + kswz<DK>(kc_ * 2 + 256, kr_);
    const unsigned voffV = (unsigned)(sr * LDV + sc) * 2u, voffK = (unsigned)(kr_ * LDK + kc_) * 2u;
    const int vb0 = (int)(unsigned)(uintptr_t)V_lds + v_rd_base(lane);
    const int kE = ((g + 1) & 1) * SHM_K, kO = (g & 1) * SHM_K, vE = (g & 1) * SHM_V, vO = ((g + 1) & 1) * SHM_V;
    bf16x8 vs0, vs1, ks0, ks1, ks2;
#define PLOADK(tile) do { const int _t = (tile) < NT ? (tile) : NT - 1; const int _r0 = __builtin_amdgcn_readfirstlane(pol.tile_row(_t));                     \
    const GAS char* _kt = (const GAS char*)Kb + (size_t)_r0 * (LDK * 2);                                                                                     \
    if constexpr (DK == 128) { ks0 = *reinterpret_cast<const GAS bf16x8*>(_kt + voffK); ks1 = *reinterpret_cast<const GAS bf16x8*>(_kt + (size_t)(32 * LDK * 2) + voffK); } \
    else { ks0 = *reinterpret_cast<const GAS bf16x8*>(_kt + voffK); ks1 = *reinterpret_cast<const GAS bf16x8*>(_kt + 128 + voffK); ks2 = *reinterpret_cast<const GAS bf16x8*>(_kt + 256 + voffK); } } while (0)
#define PLOADV(tile) do { const int _t = (tile) < NT ? (tile) : NT - 1; const int _r0 = __builtin_amdgcn_readfirstlane(pol.tile_row(_t));                     \
    const GAS char* _vt = (const GAS char*)Vb + (size_t)_r0 * (LDV * 2);                                                                                     \
    vs0 = *reinterpret_cast<const GAS bf16x8*>(_vt + voffV); vs1 = *reinterpret_cast<const GAS bf16x8*>(_vt + (size_t)(32 * LDV * 2) + voffV); } while (0)
#define PWRITEK(ko) do { *(LAS bf16x8*)(K_lds + (ko) + kst0) = ks0; *(LAS bf16x8*)(K_lds + (ko) + kst1) = ks1; if constexpr (DK == 192) *(LAS bf16x8*)(K_lds + (ko) + kst2) = ks2; } while (0)
#define PWRITEV(vo) do { *(LAS bf16x8*)(V_lds + (vo) + vst0) = vs0; *(LAS bf16x8*)(V_lds + (vo) + vst1) = vs1; } while (0)
#define PBAR() do { SBAR(); asm volatile("s_waitcnt lgkmcnt(0)\n\ts_barrier" ::: "memory"); SBAR(); } while (0)
#define PRESC(a) do { if (__any((a) < 1.f)) { if (hi == 0) al_l[r32] = (a); asm volatile("s_waitcnt lgkmcnt(0)" ::: "memory"); \
    _Pragma("unroll") for (int d = 0; d < 4; ++d) _Pragma("unroll") for (int r = 0; r < 16; ++r) o[d][r] *= al_l[crow(r, hi)]; } } while (0)
#define PSEGV(j, ko, vo) do { float mn_, al_; if (PP_PRIO) __builtin_amdgcn_s_setprio(0);                                                                        \
    asm volatile("s_waitcnt vmcnt(0)" ::: "memory"); PWRITEK(ko); PWRITEV(vo); SBAR();                  \
    if (ACCI) partialSM3(p0, p1, m_reg, al_, mpk, (j) == 0); else partialSM<DK>(p0, p1, m_reg, mn_, al_); finishSM(p0, p1, al_, l_reg, pa0, pa1, pa2, pa3); PRESC(al_);            \
    if (!(KLD_IN_M && DK == 128)) PLOADK((j) + g + 2); if (!(VLD_IN_M && DK == 128)) PLOADV((j) + g + 1); PBAR(); } while (0)
#if PP_ILV
#define PSEGM(j, kb, vb) do { if (PP_PRIO) __builtin_amdgcn_s_setprio(1); SBAR();                                                                              \
    m_seg<DK, NQR, LA>(p0, p1, o, K_lds + (kb) * SHM_K, qr, qx, r32, hi, vb0 + (vb) * SHM_V, pa0, pa1, pa2, pa3, mpk, [&]() __attribute__((always_inline)) { if (KLD_IN_M && DK == 128) PLOADK((j) + g + 1); if (VLD_IN_M && DK == 128) PLOADV((j) + g); }); pol.hook(p0, p1, (j), wid, r32, hi); PBAR(); } while (0)
#elif PP_VIS
#define PSEGM(j, kb, vb) do { VFr ga_, gb_; if (PP_PRIO) __builtin_amdgcn_s_setprio(1); SBAR();                                                                \
    qkt_pipe2<DK, NQR, LA>(p0, p1, K_lds + (kb) * SHM_K, qr, qx, r32, hi, ga_, gb_, vb0 + (vb) * SHM_V); pol.hook(p0, p1, (j), wid, r32, hi);                \
    pv_rest2(o, ga_, gb_, vb0 + (vb) * SHM_V, pa0, pa1, pa2, pa3); PBAR(); } while (0)
#else
#define PSEGM(j, kb, vb) do { VFr ga_, gb_; if (PP_PRIO) __builtin_amdgcn_s_setprio(1); SBAR(); v_req<0>(ga_, vb0 + (vb) * SHM_V); v_req<1>(gb_, vb0 + (vb) * SHM_V); SBAR();                              \
    qkt_pipe<DK, NQR, LA>(p0, p1, K_lds + (kb) * SHM_K, qr, qx, r32, hi); pol.hook(p0, p1, (j), wid, r32, hi);                                                \
    pv_rest(o, ga_, gb_, vb0 + (vb) * SHM_V, pa0, pa1, pa2, pa3); PBAR(); } while (0)
#endif
    bf16x8 pa0, pa1, pa2, pa3; f32x16 p0, p1;
    PLOADK(0); asm volatile("s_waitcnt vmcnt(0)" ::: "memory"); PWRITEK(0); PLOADK(1); PLOADV(0);
    PBAR();
    if (g) { asm volatile("s_waitcnt vmcnt(0)" ::: "memory"); PWRITEK(SHM_K); PWRITEV(0); PLOADK(2); PLOADV(1); PBAR(); }
    qkt<DK, NQR>(p0, p1, K_lds, qr, qx, r32, hi); pol.hook(p0, p1, 0, wid, r32, hi); PBAR();
    for (int j = 0; j + 2 < NT; j += 2) {
        PSEGV(j, kE, vE); PSEGM(j + 1, 1, 0);
        PSEGV(j + 1, kO, vO); PSEGM(j + 2, 0, 1);
    }
    PSEGV(NT - 2, kE, vE); PSEGM(NT - 1, 1, 0);
    PSEGV(NT - 1, kO, vO);
    { VFr ga_, gb_; SBAR(); v_req<0>(ga_, vb0 + SHM_V); v_req<1>(gb_, vb0 + SHM_V); pv_rest(o, ga_, gb_, vb0 + SHM_V, pa0, pa1, pa2, pa3); }
    if (!g) PBAR();
    if (PP_PRIO) __builtin_amdgcn_s_setprio(0);
    __syncthreads();
    if (hi == 0) li_l[r32] = l_reg; asm volatile("s_waitcnt lgkmcnt(0)" ::: "memory");
    float rli[16];
#pragma unroll
    for (int r = 0; r < 16; ++r) rli[r] = __builtin_amdgcn_rcpf(li_l[crow(r, hi)]);
    int tid_o = threadIdx.x; asm volatile("" : "+v"(tid_o));
    store_o(o, rli, lds, Ob, tid_o, hi);
#undef PLOADK
#undef PLOADV
#undef PWRITEK
#undef PWRITEV
#undef PBAR
#undef PRESC
#undef PSEGV
#undef PSEGM
}
}

#define XB_TMO      128
#define XB_XCNT(j)  (256  + 64 * (j))
#define XB_XSUB(j)  (1280 + 64 * (j))
#define XB_XGEN(j)  (2304 + 64 * (j))
#define XB_TOP      3328
#define XB_TOPGEN   3392
#define XCD_BAR_WORDS 3456
#define XB_SPIN_CAP (1u << 22)
__device__ __forceinline__ unsigned xb_ld(unsigned* p)              { return __hip_atomic_load(p, __ATOMIC_RELAXED, __HIP_MEMORY_SCOPE_AGENT); }
__device__ __forceinline__ unsigned xb_add(unsigned* p, unsigned v) { return __hip_atomic_fetch_add(p, v, __ATOMIC_RELAXED, __HIP_MEMORY_SCOPE_AGENT); }
__device__ __forceinline__ unsigned xb_xcc_id() { return (unsigned)__builtin_amdgcn_s_getreg((3 << 11) | 20) & 0xFu; }
#define XB_SPIN(cond, bar) do { unsigned _sp = 0; while (cond) { __builtin_amdgcn_s_sleep(1); \
    if ((++_sp & 255u) == 0u) { if (xb_ld(&(bar)[XB_TMO])) break; if (_sp > XB_SPIN_CAP) { atomicAdd(&(bar)[XB_TMO], 1u); break; } } } } while (0)
struct XcdBarrier { unsigned* bar; unsigned x; volatile LAS unsigned* st; };
__device__ __forceinline__ XcdBarrier xcd_barrier_post(unsigned* bar, volatile LAS unsigned* st) {
    XcdBarrier b; b.bar = bar; b.x = xb_xcc_id(); b.st = st;
    if (threadIdx.x == 0) (void)xb_add(&bar[XB_XCNT(b.x)], 1u);
    return b;
}
__device__ __forceinline__ void xcd_barrier_complete(unsigned* bar, unsigned x, unsigned& nloc, unsigned& nx) {
    const unsigned G = gridDim.x * gridDim.y * gridDim.z;
    unsigned sum, cnt, mine, sp = 0u;
    for (;;) {
        sum = 0u; cnt = 0u; mine = 0u;
#pragma unroll
        for (unsigned j = 0; j < 16; ++j) { const unsigned c = xb_ld(&bar[XB_XCNT(j)]); sum += c; cnt += (c > 0u) ? 1u : 0u; mine = (j == x) ? c : mine; }
        if (sum == G) break;
        __builtin_amdgcn_s_sleep(1);
        if ((++sp & 255u) == 0u) { if (xb_ld(&bar[XB_TMO])) break; if (sp > XB_SPIN_CAP) { atomicAdd(&bar[XB_TMO], 1u); break; } }
    }
    nloc = mine > 0u ? mine : 1u; nx = cnt > 0u ? cnt : 1u;
}
__device__ __forceinline__ void xcd_barrier(const XcdBarrier& b) {
    asm volatile("s_waitcnt vmcnt(0)" ::: "memory");
    __syncthreads();
    if (threadIdx.x == 0) {
        unsigned* bar = b.bar;
        __builtin_amdgcn_s_waitcnt(0);
        unsigned nloc = b.st[0], nx = b.st[1];
        if (nloc == 0u) { xcd_barrier_complete(bar, b.x, nloc, nx); b.st[0] = nloc; b.st[1] = nx; }
        const unsigned old = xb_add(&bar[XB_XSUB(b.x)], 1u);
        const unsigned gen = old / nloc;
        if (old + 1u == (gen + 1u) * nloc) {
            __builtin_amdgcn_fence(__ATOMIC_RELEASE, "agent");
            asm volatile("s_waitcnt vmcnt(0)" ::: "memory");
            const unsigned og = xb_add(&bar[XB_TOP], 1u);
            const unsigned tg = og / nx;
            if (og + 1u == (tg + 1u) * nx) xb_add(&bar[XB_TOPGEN], 1u);
            else XB_SPIN(xb_ld(&bar[XB_TOPGEN]) == tg, bar);
            __builtin_amdgcn_fence(__ATOMIC_ACQUIRE, "agent");
            xb_add(&bar[XB_XGEN(b.x)], 1u);
            asm volatile("s_waitcnt vmcnt(0)" ::: "memory");
        } else {
            XB_SPIN(xb_ld(&bar[XB_XGEN(b.x)]) == gen, bar);
            __builtin_amdgcn_fence(__ATOMIC_ACQUIRE, "agent");
            asm volatile("s_waitcnt vmcnt(0)" ::: "memory");
        }
    }
    __syncthreads();
}

constexpr int NWAVES = 8, NPHASES = 21;
#ifndef CV_FILL
#define CV_FILL 1
#endif
#ifndef MLA_SDEPTH
#define MLA_SDEPTH 1
#endif
#ifndef GQA_SDEPTH
#define GQA_SDEPTH 1
#endif
#ifndef GQA_NQR
#define GQA_NQR 0
#endif
#ifndef GQA_PP
#define GQA_PP 1
#endif
#ifndef MLA_PP
#define MLA_PP 1
#endif
#ifndef MLA_QLA
#define MLA_QLA 2
#endif
#ifndef MLA_PIPE
#define MLA_PIPE true
#endif
#ifndef MLA_QLDS
#define MLA_QLDS true
#endif
struct Args { const float* in[28]; float* out; unsigned char* ws; int ph_lo, ph_hi; };
#define INP(k) ((const gf32*)args.in[k])
struct Frame {
    LAS unsigned char* lds; volatile LAS unsigned* MISC; gu32* ctl;
    int tid, lane, wave, b, G;
    GAS unsigned char* ws;
    gf32* out;
};
__device__ __forceinline__ const gf32* MODP(const Frame& F, int l, int v, int ch) { return (const gf32*)(F.ws + WS_MOD) + (size_t)((l * 2 + v) * 6 + ch) * D; }

constexpr int I_IN = 16 * 17, I_UQ = 4 * 6, I_UKV = 4 * 8, I_OUT = 16 * 8, I_QKV = 16 * 12, I_O = 16 * 8, I_EXP = 96;
constexpr int NL0D = I_IN + I_UQ + I_UKV + I_OUT, NL0 = NL0D + NEX * I_EXP;
constexpr int NL1D = I_QKV + I_O, NL1 = NL1D + NEX * I_EXP;
constexpr int CW_CVQ = 8192;
__host__ __device__ __forceinline__ int ys_pos(int n) { const int q = n & 255; return (n - q) + 128 * ((q >> 3) & 1) + 32 * (q >> 6) + 8 * ((q >> 4) & 3) + (q & 7); }
struct CvTile { const gf32* src; gbf* dst; const gf32* ks; int K, N, n0, mode, aux; };
__device__ __forceinline__ CvTile cv_decode(const Frame& F, const Args& args, int it) {
    const gf32* W; gbf* WT; const gf32* ks = nullptr; int K, N, kb, nb, mode = 0, aux = 0; int r = it, l = 0; bool dense = true;
    if (r >= NL0) { r -= NL0; l = 1; }
    if (l == 0) {
        if (r < I_IN) { W = INP(8); K = D; N = NIN; WT = (gbf*)(F.ws + WS_WIN); kb = r / 17; nb = r % 17; }
        else if (r < I_IN + I_UQ) { r -= I_IN; W = INP(11); K = 512; N = 1536; WT = (gbf*)(F.ws + WS_WUQ); ks = INP(10); kb = r / 6; nb = r % 6; }
        else if (r < I_IN + I_UQ + I_UKV) { r -= I_IN + I_UQ; W = INP(13); K = 512; N = 2048; WT = (gbf*)(F.ws + WS_WUKV); ks = INP(12); kb = r / 8; nb = r % 8; }
        else if (r < NL0D) { r -= I_IN + I_UQ + I_UKV; W = INP(14); K = D; N = D; WT = (gbf*)(F.ws + WS_WOUT); kb = r / 8; nb = r % 8; }
        else { r -= NL0D; dense = false; }
    } else {
        if (r < I_QKV) { W = INP(15); K = D; N = 3072; WT = (gbf*)(F.ws + WS_WQKV); kb = r / 12; nb = r % 12; }
        else if (r < NL1D) { r -= I_QKV; W = INP(18); K = D; N = D; WT = (gbf*)(F.ws + WS_WO); kb = r / 8; nb = r % 8; }
        else { r -= NL1D; dense = false; }
    }
    if (!dense) {
        const int e = r / I_EXP, sub = r % I_EXP, mat = sub / 32, q = sub % 32;
        if (mat < 2) {
            W = e == 0 ? INP(24 + mat) + (size_t)l * D * DE : INP(21 + mat) + ((size_t)l * NE + (e - 1)) * D * DE;
            K = D; N = DE; kb = q / 2; nb = q % 2; mode = 1; aux = mat;
            WT = (gbf*)(F.ws + WS_GU + ((size_t)l * NEX + e) * GU_BYTES);
        } else {
            W = e == 0 ? INP(26) + (size_t)l * DE * D : INP(23) + ((size_t)l * NE + (e - 1)) * DE * D;
            K = DE; N = D; kb = q / 8; nb = q % 8; mode = 2;
            WT = (gbf*)(F.ws + WS_DN + ((size_t)l * NEX + e) * DN_BYTES);
        }
    }
    CvTile c; c.n0 = 256 * nb; c.mode = mode; c.aux = aux; c.src = W + (size_t)(128 * kb) * N + 256 * nb; c.dst = WT + 128 * kb; c.ks = ks ? ks + 128 * kb : nullptr; c.K = K; c.N = N; return c;
}
__device__ __forceinline__ int cv_row(const CvTile& c, int n) { return c.mode == 0 ? n : (c.mode == 1 ? 256 * (n >> 7) + 128 * c.aux + (n & 127) : ys_pos(n)); }
__device__ __forceinline__ void cv_load(const CvTile& c, f32x4 (&v)[16], int tid) {
    const int w = tid >> 6, L = tid & 63; const int col = c.n0 + 4 * L < c.N ? 4 * L : 0;
    const gf32* p = c.src + (size_t)(16 * w) * c.N + col;
#pragma unroll
    for (int r = 0; r < 16; ++r) v[r] = *(const GAS f32x4*)(p + (size_t)r * c.N);
}
__device__ __forceinline__ void cv_to_lds(const CvTile& c, f32x4 (&v)[16], LAS unsigned* img, int tid) {
    const int w = tid >> 6, L = tid & 63;
#pragma unroll
    for (int p = 0; p < 8; ++p) { f32x4 a = v[2 * p], b = v[2 * p + 1];
        if (c.ks) { a *= c.ks[16 * w + 2 * p]; b *= c.ks[16 * w + 2 * p + 1]; }
        const int kp = 8 * w + p;
        *(LAS u32x4*)(img + kp * 256 + ((L ^ (kp >> 2)) & 63) * 4) = (u32x4){pk2(a[0], b[0]), pk2(a[1], b[1]), pk2(a[2], b[2]), pk2(a[3], b[3])}; }
}
__device__ __forceinline__ void cv_from_lds(const CvTile& c, const LAS unsigned* img, int tid) {
    const int ci = tid & 15, nl = tid >> 4;
#pragma unroll
    for (int q = 0; q < 8; ++q) { const int n = nl + 32 * q, nt = c.n0 + n;
        u32x4 o;
#pragma unroll
        for (int i = 0; i < 4; ++i) o[i] = img[(4 * ci + i) * 256 + (((n >> 2) ^ ci) & 63) * 4 + (n & 3)];
        if (nt < c.N) *(GAS u32x4*)(c.dst + (size_t)cv_row(c, nt) * c.K + 8 * ci) = o; }
}
__device__ __forceinline__ int cv_run_drain(const Frame& F, const Args& args, int it0, int step, int end) {
    LAS unsigned* img = (LAS unsigned*)(F.lds + RING_OFF);
    f32x4 va[16], vb[16]; CvTile ca, cb; int it = it0;
    const int last = it0 + ((end - 1 - it0) / step) * step;
#define CV_CLAMP(x) ((x) < end ? (x) : last)
    ca = cv_decode(F, args, it); cv_load(ca, va, F.tid);
    cb = cv_decode(F, args, CV_CLAMP(it + step)); cv_load(cb, vb, F.tid);
#define CV_STEP(CUR, VCUR) { const CvTile _old = CUR;                                                                                       \
        __syncthreads(); cv_to_lds(_old, VCUR, img, F.tid);                                                                                  \
        CUR = cv_decode(F, args, CV_CLAMP(it + 2 * step)); cv_load(CUR, VCUR, F.tid);                                                        \
        __syncthreads(); cv_from_lds(_old, img, F.tid);                                                                                      \
        it += step; if (it >= end) break; }
    for (;;) {
        CV_STEP(ca, va)
        CV_STEP(cb, vb)
    }
#undef CV_STEP
#undef CV_CLAMP
    asm volatile("s_waitcnt vmcnt(0)" ::: "memory");
    __syncthreads();
    return end;
}
__device__ __forceinline__ int cv_run_seq(const Frame& F, const Args& args, int it0, int step, int end, gu32* done_word = nullptr, unsigned done_target = 0u) {
    if (it0 >= end) return it0;
    if (CV_DEEP_DRAIN && done_word == nullptr) return cv_run_drain(F, args, it0, step, end);
    LAS unsigned* img = (LAS unsigned*)(F.lds + RING_OFF); volatile LAS unsigned* flag = F.MISC + 40;
    f32x4 va[16], vb[16]; CvTile ca, cb; int it = it0, ret = end;
    ca = cv_decode(F, args, it); cv_load(ca, va, F.tid);
    for (;;) {
        const int n1 = it + step; const bool h1 = n1 < end;
        cb = cv_decode(F, args, h1 ? n1 : it); cv_load(cb, vb, F.tid);
        if (done_word && F.tid == 0) flag[0] = __hip_atomic_load(done_word, RLX_AGENT) >= done_target ? 1u : 0u;
        __syncthreads(); cv_to_lds(ca, va, img, F.tid); __syncthreads(); cv_from_lds(ca, img, F.tid);
        if (!h1) break;
        if (done_word && flag[0]) { ret = n1; break; }
        const int n2 = n1 + step; const bool h2 = n2 < end;
        ca = cv_decode(F, args, h2 ? n2 : n1); cv_load(ca, va, F.tid);
        if (done_word && F.tid == 0) flag[1] = __hip_atomic_load(done_word, RLX_AGENT) >= done_target ? 1u : 0u;
        __syncthreads(); cv_to_lds(cb, vb, img, F.tid); __syncthreads(); cv_from_lds(cb, img, F.tid);
        if (!h2) break;
        if (done_word && flag[1]) { ret = n2; break; }
        it = n2;
    }
    asm volatile("s_waitcnt vmcnt(0)" ::: "memory");
    __syncthreads();
    return ret;
}
constexpr int NQ = NEX * I_EXP + NL1, NQ_L0E = NEX * I_EXP, NQ_L1D = NQ_L0E + NL1D, CW_DONE = 8256, CW_PEND = 8320, CVB = 8;
__device__ __forceinline__ void cv_fill(const Frame& F, const Args& args, int q_limit, gu32* done_word, unsigned done_target) {
    volatile LAS unsigned* slot = F.MISC + 32; gu32* pw = F.ctl + CW_PEND + 2 * F.b;
    for (;;) {
        if (F.tid == 0) { unsigned nxt = __hip_atomic_load(pw, RLX_AGENT), en = __hip_atomic_load(pw + 1, RLX_AGENT), ex = 0u;
            if (nxt >= en) {
                const bool stop = (done_word && __hip_atomic_load(done_word, RLX_AGENT) >= done_target) || __hip_atomic_load(F.ctl + CW_CVQ, RLX_AGENT) >= (unsigned)q_limit;
                if (stop) ex = 1u;
                else { nxt = __hip_atomic_fetch_add(F.ctl + CW_CVQ, (unsigned)CVB, RLX_AGENT);
                    if (nxt >= (unsigned)NQ) ex = 1u; else { en = nxt + CVB < (unsigned)NQ ? nxt + CVB : (unsigned)NQ; __hip_atomic_store(pw + 1, en, RLX_AGENT); __hip_atomic_store(pw, nxt, RLX_AGENT); } } }
            slot[0] = nxt; slot[1] = en; slot[2] = ex; }
        __syncthreads();
        const unsigned nxt = slot[0], en = slot[1], ex = slot[2];
        __syncthreads();
        if (ex) break;
        const int r = cv_run_seq(F, args, NL0D + (int)nxt, 1, NL0D + (int)en, done_word, done_target) - NL0D;
        if (F.tid == 0) __hip_atomic_store(pw, (unsigned)r, RLX_AGENT);
        if (r < (int)en) break;
    }
}
__device__ __forceinline__ void p0_prologue(Frame& F, const Args& args) {
    const int gw = F.b * NWAVES + F.wave, NGW = F.G * NWAVES, lane = F.lane;
    { LAS f32x4* red = (LAS f32x4*)(F.lds + RING_OFF);
      LAS float* sl = (LAS float*)(F.lds + RING_OFF + 32768);
      for (int i = F.tid; i < 2 * D; i += 512) { const float a = i < D ? INP(1)[i] : INP(3)[i - D]; sl[i] = a / (1.f + __expf(-a)); }
      __syncthreads();
      for (int it = F.b; it < 768; it += F.G) {
        const int l = it / 384, kc = (it % 384) / 48, cg = it % 48, k0 = kc * 256 + 32 * F.wave;
        const gf32* W = INP(4) + (size_t)l * D * 12288 + (size_t)k0 * 12288 + cg * 256 + lane * 4;
        f32x4 al = {0.f, 0.f, 0.f, 0.f}, ac = {0.f, 0.f, 0.f, 0.f};
#pragma unroll 16
        for (int k = 0; k < 32; ++k) { const f32x4 w = *(const GAS f32x4*)(W + (size_t)k * 12288);
            al += w * sl[k0 + k]; ac += w * sl[D + k0 + k]; }
        red[(F.wave * 2) * 64 + lane] = al; red[(F.wave * 2 + 1) * 64 + lane] = ac;
        __syncthreads();
        if (F.tid < 128) { const int vv = F.tid >> 6; f32x4 s = red[vv * 64 + lane];
#pragma unroll
            for (int ww = 1; ww < 8; ++ww) s += red[(ww * 2 + vv) * 64 + lane];
            *(GAS f32x4*)((gf32*)(F.ws + WS_PART) + (size_t)((l * 8 + kc) * 2 + vv) * 12288 + cg * 256 + lane * 4) = s; }
        __syncthreads();
      } }
    for (int t = gw; t < T; t += NGW) {
        float cm = 1.f, sm = 0.f, cg_ = 1.f, sg = 0.f;
        if (t >= CTX) { const int p = t - CTX; const float row = (float)(p / 64), col = (float)(p % 64);
            { const int i = lane & 31, ii = i & 15; const float inv = powf(10000.f, -(float)ii / 16.f); const float ang = (i < 16 ? row : col) * inv; sincosf(ang, &sm, &cm); }
            { const int i = lane, ii = i & 31; const float inv = powf(10000.f, -(float)ii / 32.f); const float ang = (i < 32 ? row : col) * inv; sincosf(ang, &sg, &cg_); } }
        if (lane < 32) *(GAS f32x2*)((gf32*)(F.ws + WS_TABM) + ((size_t)t * 32 + lane) * 2) = (f32x2){cm, sm};
        *(GAS f32x2*)((gf32*)(F.ws + WS_TABG) + ((size_t)t * 64 + lane) * 2) = (f32x2){cg_, sg};
    }
    { GAS u32x4* z = (GAS u32x4*)(F.ws + WS_WIN + (size_t)NIN * D * 2); const int n16 = (NINP - NIN) * D * 2 / 16;
      for (int i = F.b * 512 + F.tid; i < n16; i += F.G * 512) z[i] = (u32x4){0u, 0u, 0u, 0u}; }
    for (int idx = F.b * 512 + F.tid; idx < 2 * NE * D; idx += F.G * 512) { const int l = idx / (NE * D), e = (idx / D) % NE, k = idx % D;
        const float w = INP(19)[((size_t)l * D + k) * NE + e]; const unsigned hi = f2bf(w); const float lo = w - bf2f_lo(hi);
        gbf* o = (gbf*)(F.ws + WS_WRT) + (size_t)l * 2 * NE * D + (size_t)e * D + k; o[0] = (bf16_t)hi; o[(size_t)NE * D] = (bf16_t)f2bf(lo); }
    cv_run_seq(F, args, F.b, F.G, NL0D);
}

__device__ __forceinline__ void norm_mod_store(const f32x4 (&v)[8], const gf32* g, const gf32* shift, const gf32* scale, gbf* dst, int lane) {
    float ss = 0.f;
#pragma unroll
    for (int j = 0; j < 8; ++j) ss += (v[j][0] * v[j][0] + v[j][1] * v[j][1]) + (v[j][2] * v[j][2] + v[j][3] * v[j][3]);
    const float rs = rsqrtf(wave_sum(ss) * (1.f / D) + EPS);
#pragma unroll
    for (int j = 0; j < 8; ++j) { const int c = 4 * lane + 256 * j;
        const f32x4 gg = *(const GAS f32x4*)(g + c), sh = *(const GAS f32x4*)(shift + c), sc = *(const GAS f32x4*)(scale + c);
        const f32x4 y = v[j] * rs * gg, h = y * (sc + 1.f) + sh;
        *(GAS u32x2*)(dst + c) = (u32x2){pk2(h[0], h[1]), pk2(h[2], h[3])}; }
}
__device__ __forceinline__ void p1_prenorm0(Frame& F, const Args& args) {
    const gf32* PART = (const gf32*)(F.ws + WS_PART); const gf32* ada_b = INP(5);
    { const int g = F.b * 512 + F.tid;
      if (g < 2 * 2 * 12288) { const int l = g / 24576, v = (g / 12288) % 2, j = g % 12288; float s = ada_b[l * 12288 + j];
#pragma unroll
          for (int kc = 0; kc < 8; ++kc) s += PART[(size_t)((l * 8 + kc) * 2 + v) * 12288 + j];
          ((gf32*)(F.ws + WS_MOD))[g] = s; } }
    LAS float* mv = (LAS float*)(F.lds + RING_OFF);
    for (int idx = F.tid; idx < 4 * D; idx += 512) { const int v = idx / (2 * D), j = idx % (2 * D); float s = ada_b[j];
#pragma unroll
        for (int kc = 0; kc < 8; ++kc) s += PART[(size_t)(kc * 2 + v) * 12288 + j];
        mv[idx] = s; }
    __syncthreads();
    const gf32* g = INP(6);
    for (int row = F.b * NWAVES + F.wave; row < T; row += F.G * NWAVES) {
        const int v = row < CTX ? 1 : 0; const gf32* src = row < CTX ? INP(2) + (size_t)row * D : INP(0) + (size_t)(row - CTX) * D;
        f32x4 x[8]; float ss = 0.f;
#pragma unroll
        for (int j = 0; j < 8; ++j) { x[j] = *(const GAS f32x4*)(src + 4 * F.lane + 256 * j); ss += (x[j][0] * x[j][0] + x[j][1] * x[j][1]) + (x[j][2] * x[j][2] + x[j][3] * x[j][3]); }
        const float rs = rsqrtf(wave_sum(ss) * (1.f / D) + EPS);
        gbf* dst = (gbf*)(F.ws + WS_XS) + (size_t)row * D;
#pragma unroll
        for (int j = 0; j < 8; ++j) { const int c = 4 * F.lane + 256 * j;
            const f32x4 gg = *(const GAS f32x4*)(g + c), sh = *(const LAS f32x4*)(mv + v * 2 * D + c), sc = *(const LAS f32x4*)(mv + v * 2 * D + D + c);
            const f32x4 y = x[j] * rs * gg, h = y * (sc + 1.f) + sh;
            *(GAS u32x2*)(dst + c) = (u32x2){pk2(h[0], h[1]), pk2(h[2], h[3])}; }
    }
    __syncthreads();
}
__device__ __forceinline__ void p3_small(Frame& F, const Args& args) {
    const gbf* QKV = (const gbf*)(F.ws + WS_QKV); gf32* rs = (gf32*)(F.ws + WS_RS); gbf* KF = (gbf*)(F.ws + WS_KF); const gf32* tab = (const gf32*)(F.ws + WS_TABM);
    for (int t = F.b * NWAVES + F.wave; t < T; t += F.G * NWAVES) {
        const gbf* row = QKV + (size_t)t * NINP;
        const u32x4 a = *(const GAS u32x4*)(row + 3072 + 8 * F.lane), b = *(const GAS u32x4*)(row + 3584 + 8 * F.lane);
        float sa = 0.f, sb = 0.f;
#pragma unroll
        for (int i = 0; i < 4; ++i) { const float a0 = bf2f_lo(a[i]), a1 = bf2f_hi(a[i]), b0 = bf2f_lo(b[i]), b1 = bf2f_hi(b[i]); sa += a0 * a0 + a1 * a1; sb += b0 * b0 + b1 * b1; }
        sa = wave_sum(sa); sb = wave_sum(sb);
        if (F.lane == 0) { rs[t] = rsqrtf(sa * (1.f / 512.f) + EPS); rs[T + t] = rsqrtf(sb * (1.f / 512.f) + EPS); }
        if (F.lane < 32) { const unsigned w = *(const GAS unsigned*)(row + 4096 + 2 * F.lane); const float x1 = bf2f_lo(w), x2 = bf2f_hi(w);
            const f32x2 cs = *(const GAS f32x2*)(tab + ((size_t)t * 32 + F.lane) * 2);
            const unsigned o = pk2(x1 * cs[0] - x2 * cs[1], x1 * cs[1] + x2 * cs[0]);
#pragma unroll
            for (int h = 0; h < 8; ++h) *(GAS unsigned*)(KF + (size_t)t * 1536 + h * 192 + 128 + 2 * F.lane) = o; }
    }
}
__device__ __forceinline__ void p13_qknorm(Frame& F, const Args& args) {
    gbf* QKV = (gbf*)(F.ws + WS_QKV); const gf32* tab = (const gf32*)(F.ws + WS_TABG);
    const int sub = F.lane & 15;
    for (int t = F.b * NWAVES + F.wave; t < T; t += F.G * NWAVES) {
#pragma unroll
        for (int it = 0; it < 5; ++it) { const int head = it * 4 + (F.lane >> 4);
            gbf* p = QKV + (size_t)t * 3072 + head * 128 + sub * 8;
            const u32x4 w = *(const GAS u32x4*)p; float x[8];
#pragma unroll
            for (int i = 0; i < 4; ++i) { x[2 * i] = bf2f_lo(w[i]); x[2 * i + 1] = bf2f_hi(w[i]); }
            float ss = 0.f;
#pragma unroll
            for (int i = 0; i < 8; ++i) ss += x[i] * x[i];
            ss += __shfl_xor(ss, 1); ss += __shfl_xor(ss, 2); ss += __shfl_xor(ss, 4); ss += __shfl_xor(ss, 8);
            const float rs = rsqrtf(ss * (1.f / 128.f) + EPS);
            const gf32* g = (head < 16 ? INP(16) : INP(17)) + sub * 8;
            const f32x4 g0 = *(const GAS f32x4*)g, g1 = *(const GAS f32x4*)(g + 4);
#pragma unroll
            for (int i = 0; i < 4; ++i) { x[i] = x[i] * rs * g0[i]; x[4 + i] = x[4 + i] * rs * g1[i]; }
            const f32x4 t0 = *(const GAS f32x4*)(tab + ((size_t)t * 64 + sub * 4) * 2), t1 = *(const GAS f32x4*)(tab + ((size_t)t * 64 + sub * 4 + 2) * 2);
            u32x4 o;
            o.x = pk2(x[0] * t0[0] - x[1] * t0[1], x[0] * t0[1] + x[1] * t0[0]); o.y = pk2(x[2] * t0[2] - x[3] * t0[3], x[2] * t0[3] + x[3] * t0[2]);
            o.z = pk2(x[4] * t1[0] - x[5] * t1[1], x[4] * t1[1] + x[5] * t1[0]); o.w = pk2(x[6] * t1[2] - x[7] * t1[3], x[6] * t1[3] + x[7] * t1[2]);
            *(GAS u32x4*)p = o; }
    }
}

__device__ __forceinline__ void moe_router(Frame& F, const Args& args, int l) {
    const int row_off = l ? CTX : 0, per = l ? 32 : 33; const bool EX = (l == 0);
    const int tid = F.tid, lane = F.lane, w = F.wave, i = lane & 31, hh = lane >> 5;
    LAS float* part = (LAS float*)(F.lds + RING_OFF);
    LAS float* logits = (LAS float*)(F.lds + RING_OFF + 65536);
    LAS float* red = (LAS float*)(F.lds + RING_OFF + 65536 + 16384);
    LAS float* redx = red + 256;
    LAS float* partx = red + 512;
    volatile LAS unsigned* hist = F.MISC + 64;
    if (tid < 64) hist[tid] = 0u;
    __syncthreads();
    const gbf* X1 = (const gbf*)(F.ws + WS_X1); gbf* XS = (gbf*)(F.ws + WS_XS);
    const gf32* fn = INP(7) + (size_t)l * D; const gf32* Wr = INP(19) + (size_t)l * D * NE; const gf32* rb = INP(20) + l * NE;
    gu32* tok_e = (gu32*)(F.ws + WS_TOKE); gf32* tok_w = (gf32*)(F.ws + WS_TOKW); gu32* tok_s = (gu32*)(F.ws + WS_TOKS);
    for (int g = F.b; g < 256; g += F.G) {
        const int t0 = g * per, t = t0 + i, tx = t0 + 32;
        const bool v = (l == 0 && t < CTX), vx = (l == 0 && tx < CTX);
        const int ko = 256 * w + 8 * hh;
        const gbf* xrow = X1 + (size_t)(row_off + t) * D + ko; const gbf* xrx = X1 + (size_t)(row_off + tx) * D + ko;
        const gf32* shp = (v ? MODP(F, l, 1, 3) : MODP(F, l, 0, 3)) + ko; const gf32* scp = (v ? MODP(F, l, 1, 4) : MODP(F, l, 0, 4)) + ko; const gf32* fnp = fn + ko;
        const gf32* shx = (vx ? MODP(F, l, 1, 3) : MODP(F, l, 0, 3)) + ko; const gf32* scx = (vx ? MODP(F, l, 1, 4) : MODP(F, l, 0, 4)) + ko;
        float ss = 0.f, ssx = 0.f;
#pragma unroll 4
        for (int s = 0; s < 16; ++s) { f32x4 x0, x1; x1_ld8(xrow + 16 * s, x0, x1);
            ss += ((x0[0] * x0[0] + x0[1] * x0[1]) + (x0[2] * x0[2] + x0[3] * x0[3])) + ((x1[0] * x1[0] + x1[1] * x1[1]) + (x1[2] * x1[2] + x1[3] * x1[3]));
            if (EX) { f32x4 y0, y1; x1_ld8(xrx + 16 * s, y0, y1);
                ssx += ((y0[0] * y0[0] + y0[1] * y0[1]) + (y0[2] * y0[2] + y0[3] * y0[3])) + ((y1[0] * y1[0] + y1[1] * y1[1]) + (y1[2] * y1[2] + y1[3] * y1[3])); } }
        ss += __shfl_xor(ss, 32); ssx += __shfl_xor(ssx, 32);
        if (hh == 0) red[w * 32 + i] = ss;
        if (lane == 0) redx[w] = ssx;
        __syncthreads();
        float tot = 0.f, totx = 0.f;
#pragma unroll
        for (int q = 0; q < 8; ++q) { tot += red[q * 32 + i]; totx += redx[q]; }
        const float rs = rsqrtf(tot * (1.f / D) + EPS), rsx = rsqrtf(totx * (1.f / D) + EPS);
        f32x16 acc0 = {}, acc1 = {}; float ax0 = 0.f, ax1 = 0.f;
        gbf* xs = XS + (size_t)t * D + ko; gbf* xsx = XS + (size_t)tx * D + ko;
        const gbf* wt0 = (const gbf*)(F.ws + WS_WRT) + (size_t)l * 2 * NE * D + (size_t)i * D + ko;
#pragma unroll 2
        for (int s = 0; s < 16; ++s) {
            f32x4 h0, h1;
            { f32x4 x0, x1; x1_ld8(xrow + 16 * s, x0, x1);
              const f32x4 g0 = *(const GAS f32x4*)(fnp + 16 * s), g1 = *(const GAS f32x4*)(fnp + 16 * s + 4);
              h0 = (x0 * rs * g0) * (*(const GAS f32x4*)(scp + 16 * s) + 1.f) + *(const GAS f32x4*)(shp + 16 * s);
              h1 = (x1 * rs * g1) * (*(const GAS f32x4*)(scp + 16 * s + 4) + 1.f) + *(const GAS f32x4*)(shp + 16 * s + 4);
              if (EX) { f32x4 y0, y1; x1_ld8(xrx + 16 * s, y0, y1);
                  const f32x4 hx0 = (y0 * rsx * g0) * (*(const GAS f32x4*)(scx + 16 * s) + 1.f) + *(const GAS f32x4*)(shx + 16 * s);
                  const f32x4 hx1 = (y1 * rsx * g1) * (*(const GAS f32x4*)(scx + 16 * s + 4) + 1.f) + *(const GAS f32x4*)(shx + 16 * s + 4);
                  if (i == 0) *(GAS u32x4*)(xsx + 16 * s) = (u32x4){pk2(hx0[0], hx0[1]), pk2(hx0[2], hx0[3]), pk2(hx1[0], hx1[1]), pk2(hx1[2], hx1[3])};
#pragma unroll
                  for (int c = 0; c < 2; ++c) { const u32x4 wh = *(const GAS u32x4*)(wt0 + (size_t)c * 32 * D + 16 * s), wl = *(const GAS u32x4*)(wt0 + (size_t)(NE + c * 32) * D + 16 * s);
                      float a = 0.f;
#pragma unroll
                      for (int q = 0; q < 4; ++q) { const float w0 = bf2f_lo(wh[q]) + bf2f_lo(wl[q]), w1 = bf2f_hi(wh[q]) + bf2f_hi(wl[q]);
                          const float e0 = q < 2 ? hx0[2 * q] : hx1[2 * q - 4], e1 = q < 2 ? hx0[2 * q + 1] : hx1[2 * q - 3]; a = fmaf(e0, w0, a); a = fmaf(e1, w1, a); }
                      if (c == 0) ax0 += a; else ax1 += a; } } }
            const u32x4 hhi = {pk2(h0[0], h0[1]), pk2(h0[2], h0[3]), pk2(h1[0], h1[1]), pk2(h1[2], h1[3])};
            *(GAS u32x4*)(xs + 16 * s) = hhi;
            u32x4 hlo;
            hlo[0] = pk2(h0[0] - bf2f_lo(hhi[0]), h0[1] - bf2f_hi(hhi[0])); hlo[1] = pk2(h0[2] - bf2f_lo(hhi[1]), h0[3] - bf2f_hi(hhi[1]));
            hlo[2] = pk2(h1[0] - bf2f_lo(hhi[2]), h1[1] - bf2f_hi(hhi[2])); hlo[3] = pk2(h1[2] - bf2f_lo(hhi[3]), h1[3] - bf2f_hi(hhi[3]));
            const bf16x8 ahi = __builtin_bit_cast(bf16x8, hhi), alo = __builtin_bit_cast(bf16x8, hlo);
            { const bf16x8 bh = *(const GAS bf16x8*)(wt0 + 16 * s), bl = *(const GAS bf16x8*)(wt0 + (size_t)NE * D + 16 * s);
              acc0 = __builtin_amdgcn_mfma_f32_32x32x16_bf16(ahi, bh, acc0, 0, 0, 0); acc0 = __builtin_amdgcn_mfma_f32_32x32x16_bf16(ahi, bl, acc0, 0, 0, 0); acc0 = __builtin_amdgcn_mfma_f32_32x32x16_bf16(alo, bh, acc0, 0, 0, 0); }
            { const bf16x8 bh = *(const GAS bf16x8*)(wt0 + (size_t)32 * D + 16 * s), bl = *(const GAS bf16x8*)(wt0 + (size_t)(NE + 32) * D + 16 * s);
              acc1 = __builtin_amdgcn_mfma_f32_32x32x16_bf16(ahi, bh, acc1, 0, 0, 0); acc1 = __builtin_amdgcn_mfma_f32_32x32x16_bf16(ahi, bl, acc1, 0, 0, 0); acc1 = __builtin_amdgcn_mfma_f32_32x32x16_bf16(alo, bh, acc1, 0, 0, 0); }
        }
#pragma unroll
        for (int r = 0; r < 16; ++r) { const int row = (r & 3) + 8 * (r >> 2) + 4 * hh; part[(w * 32 + row) * 64 + i] = acc0[r]; part[(w * 32 + row) * 64 + 32 + i] = acc1[r]; }
        if (EX) { ax0 += __shfl_xor(ax0, 32); ax1 += __shfl_xor(ax1, 32); if (hh == 0) { partx[w * 64 + i] = ax0; partx[w * 64 + 32 + i] = ax1; } }
        __syncthreads();
#pragma unroll
        for (int q = 0; q < 4; ++q) { const int idx = tid + 512 * q; float s = 0.f;
#pragma unroll
            for (int ww = 0; ww < 8; ++ww) s += part[ww * 2048 + idx];
            logits[idx] = s; }
        if (EX && tid < 64) { float s = 0.f;
#pragma unroll
            for (int ww = 0; ww < 8; ++ww) s += partx[ww * 64 + tid];
            logits[2048 + tid] = s; }
        __syncthreads();
        const int nq = (EX && w == 0) ? 5 : 4;
#pragma unroll 1
        for (int q = 0; q < nq; ++q) {
            const int ti = q < 4 ? 4 * w + q : 32, tt = t0 + ti;
            const float lg = logits[ti * 64 + lane], score = 1.f / (1.f + __expf(-lg)), sel = score + rb[lane];
            int rank = 0;
#pragma unroll
            for (int d = 1; d < 8; ++d) { const float o = __shfl_xor(sel, d); rank += ((o > sel) || (o == sel && (lane ^ d) < lane)) ? 1 : 0; }
            float gsum = rank < 2 ? sel : 0.f;
            gsum += __shfl_xor(gsum, 1); gsum += __shfl_xor(gsum, 2); gsum += __shfl_xor(gsum, 4);
            int grank = 0; const int gi = lane >> 3;
#pragma unroll
            for (int m = 1; m < 8; ++m) { const float o = __shfl_xor(gsum, 8 * m); grank += ((o > gsum) || (o == gsum && (gi ^ m) < gi)) ? 1 : 0; }
            const bool gsel = grank < 4;
            const float msk = gsel ? sel : -__builtin_inff();
            int erank = 0;
#pragma unroll 8
            for (int j = 0; j < 64; ++j) { const float o = __shfl(msk, j); erank += ((o > msk) || (o == msk && j < lane)) ? 1 : 0; }
            const bool chosen = gsel && erank < TOPK;
            const float ssum = wave_sum(chosen ? score : 0.f);
            if (chosen) { tok_e[(size_t)tt * 8 + erank] = (unsigned)lane; tok_w[(size_t)tt * 8 + erank] = score / ssum * 2.5f;
                tok_s[(size_t)tt * 8 + erank] = __hip_atomic_fetch_add((LAS unsigned*)&hist[lane], 1u, __ATOMIC_RELAXED, __HIP_MEMORY_SCOPE_WORKGROUP); }
        }
        __syncthreads();
    }
    __syncthreads();
    const int Tn = l ? SEQ : T;
    volatile LAS unsigned* base = F.MISC + 128; volatile LAS unsigned* cntl = F.MISC + 192; volatile LAS unsigned* bstart = F.MISC + 1280;
    if (tid < 64) { const unsigned c = hist[tid]; bstart[tid] = c ? __hip_atomic_fetch_add(F.ctl + CW_CNT + 256 * l + tid, c, RLX_AGENT) : 0u; }
    __syncthreads();
    if (tid == 0) { gu32* arr = F.ctl + CW_ARR + 64 * l; unsigned* xb = (unsigned*)F.ctl + CW_BAR;
        __hip_atomic_fetch_add(arr, 1u, RLX_AGENT);
        unsigned sp = 0u;
        while (__hip_atomic_load(arr, RLX_AGENT) < (unsigned)F.G) { __builtin_amdgcn_s_sleep(1);
            if ((++sp & 255u) == 0u) { if (xb_ld(&xb[XB_TMO])) break; if (sp > XB_SPIN_CAP) { atomicAdd(&xb[XB_TMO], 1u); break; } } } }
    __syncthreads();
    GAS int* slot_t = (GAS int*)(F.ws + WS_SLOTT); gf32* slot_w = (gf32*)(F.ws + WS_SLOTW);
    if (tid < 64) {
        const unsigned c = __hip_atomic_load(F.ctl + CW_CNT + 256 * l + lane, RLX_AGENT), p = (c + 255u) / 256u;
        unsigned inc = p;
#pragma unroll
        for (int o = 1; o < 64; o <<= 1) { const unsigned y = __shfl_up(inc, o); if (lane >= o) inc += y; }
        const unsigned exc = inc - p, total = __shfl(inc, 63);
        base[lane] = (unsigned)Tn + 256u * exc; cntl[lane] = c;
        if (F.b == 0) { GAS int* te = (GAS int*)(F.ws + WS_TILEE) + l * 1024; const int pm0 = Tn / 256;
            for (int q = lane; q < pm0; q += 64) te[16 + q] = 0;
            for (unsigned q = 0; q < p; ++q) te[16 + pm0 + exc + q] = lane + 1;
            if (lane == 0) te[0] = pm0 + (int)total; }
    }
    __syncthreads();
    if (F.b < NE) { const unsigned c = cntl[F.b], b0 = base[F.b], pe = (c + 255u) / 256u * 256u;
        for (unsigned q = c + tid; q < pe; q += 512) slot_t[b0 + q] = 0; }
    for (int g = F.b; g < 256; g += F.G) {
        const int t0 = g * per;
        for (int p = tid; p < per * 9; p += 512) { const int ti = p / 9, k = p % 9, t = t0 + ti;
            if (k == 8) { slot_w[t] = 1.f; slot_t[t] = t; }
            else { const unsigned e = tok_e[(size_t)t * 8 + k]; const unsigned pos = base[e] + bstart[e] + tok_s[(size_t)t * 8 + k];
                tok_s[(size_t)t * 8 + k] = pos; slot_w[pos] = tok_w[(size_t)t * 8 + k]; slot_t[pos] = t; } } }
}
__device__ __forceinline__ void moe_combine(Frame& F, const Args& args, int l) {
    const int Tn = l ? SEQ : T, row_off = l ? CTX : 0, lane = F.lane;
    const GAS unsigned char* YS = F.ws + WS_YS; gbf* X1 = (gbf*)(F.ws + WS_X1); const gu32* tok_s = (const gu32*)(F.ws + WS_TOKS);
    for (int t = F.b * NWAVES + F.wave; t < Tn; t += F.G * NWAVES) {
        const int v = (l == 0 && t < CTX) ? 1 : 0; const gf32* gate = MODP(F, l, v, 5);
        unsigned sl = 0u; if (lane < 8) sl = tok_s[(size_t)t * 8 + lane];
        unsigned rows[9]; rows[0] = (unsigned)t;
#pragma unroll
        for (int k = 0; k < 8; ++k) rows[1 + k] = __shfl(sl, k);
        gbf* xr = X1 + (size_t)(row_off + t) * D;
        LAS float* xl = (LAS float*)(F.lds + RING_OFF) + F.wave * D;
        float ss = 0.f;
#pragma unroll
        for (int j = 0; j < 2; ++j) { const int c = 16 * lane + 1024 * j; float a[16];
#pragma unroll
            for (int q = 0; q < 16; ++q) a[q] = 0.f;
#pragma unroll
            for (int k = 0; k < 9; ++k) { const u32x4 y = *(const GAS u32x4*)(YS + (size_t)rows[k] * D + c);
#pragma unroll
                for (int q = 0; q < 4; ++q) { const f32x2 lo = __builtin_amdgcn_cvt_pk_f32_fp8((int)y[q], false), hi = __builtin_amdgcn_cvt_pk_f32_fp8((int)y[q], true);
                    a[4 * q] += lo[0]; a[4 * q + 1] += lo[1]; a[4 * q + 2] += hi[0]; a[4 * q + 3] += hi[1]; } }
#pragma unroll
            for (int q = 0; q < 4; ++q) { const f32x4 x = x1_ld4(xr + c + 4 * q), g = *(const GAS f32x4*)(gate + c + 4 * q) * (1.f / pg8::YS_SCALE);
                const f32x4 y = x + g * (f32x4){a[4 * q], a[4 * q + 1], a[4 * q + 2], a[4 * q + 3]};
                ss += (y[0] * y[0] + y[1] * y[1]) + (y[2] * y[2] + y[3] * y[3]);
                *(LAS f32x4*)(xl + c + 4 * q) = y;
                if (l == 0) x1_st4(xr + c + 4 * q, y); } }
        const float rs = rsqrtf(wave_sum(ss) * (1.f / D) + EPS);
        if (l == 0) {
            const gf32* g = INP(6) + D; const gf32* sh = MODP(F, 1, v, 0); const gf32* sc = MODP(F, 1, v, 1); gbf* dst = (gbf*)(F.ws + WS_XS) + (size_t)t * D;
#pragma unroll 1
            for (int j = 0; j < 2; ++j) { const int c = 16 * lane + 1024 * j; float h[16];
#pragma unroll
                for (int hq = 0; hq < 4; ++hq) { const f32x4 x = *(const LAS f32x4*)(xl + c + 4 * hq), gg = *(const GAS f32x4*)(g + c + 4 * hq), s1 = *(const GAS f32x4*)(sc + c + 4 * hq), s0 = *(const GAS f32x4*)(sh + c + 4 * hq);
                    const f32x4 y = (x * rs * gg) * (s1 + 1.f) + s0; h[4 * hq] = y[0]; h[4 * hq + 1] = y[1]; h[4 * hq + 2] = y[2]; h[4 * hq + 3] = y[3]; }
                *(GAS u32x4*)(dst + c) = (u32x4){pk2(h[0], h[1]), pk2(h[2], h[3]), pk2(h[4], h[5]), pk2(h[6], h[7])};
                *(GAS u32x4*)(dst + c + 8) = (u32x4){pk2(h[8], h[9]), pk2(h[10], h[11]), pk2(h[12], h[13]), pk2(h[14], h[15])}; }
        } else {
            const gf32* g = INP(27); gf32* o = F.out + (size_t)t * D;
#pragma unroll 1
            for (int j = 0; j < 2; ++j) { const int c = 16 * lane + 1024 * j;
#pragma unroll
                for (int hq = 0; hq < 4; ++hq) { const f32x4 x = *(const LAS f32x4*)(xl + c + 4 * hq), gg = *(const GAS f32x4*)(g + c + 4 * hq);
                    *(GAS f32x4*)(o + c + 4 * hq) = x * rs * gg; } }
        }
    }
}

#if MK_ONE_LAUNCH
#define GRID_BAR() xcd_barrier(bar)
#else
#define GRID_BAR() do {} while (0)
#endif
#define IN(k) (lo <= (k) && (k) < hi)
#define BOTH(k) (IN(k) && IN((k) + 1))
#ifndef DBG_REP
#define DBG_REP 0
#endif
#define REP_BEGIN(k) for (int rep_ = 0; rep_ < 1 + ((DBG_REP >> (k)) & 1); ++rep_) { if (rep_) GRID_BAR();
#define REP_END() }
#ifndef FILL_BIG
#define FILL_BIG 4
#endif
#ifndef FILL_SMALL
#define FILL_SMALL 0
#endif
#define GP_OF(nun) ({ const int _n = (nun), _r = (_n + F.G - 1) / F.G; (_n + _r - 1) / _r; })
#define PHASE_DONE(k) do { if (F.tid == 0) __hip_atomic_fetch_add(F.ctl + CW_DONE + (k), 1u, RLX_AGENT); } while (0)
template <int l>
__device__ __forceinline__ void layer_phases(Frame& F, const Args& args, const XcdBarrier& bar, const int lo, const int hi) {
    LAS unsigned char* ring = F.lds + RING_OFF;
    constexpr int pb = l ? 12 : 2;
    if constexpr (l == 0) {
        if (IN(2)) {
            const int Gp = GP_OF((T / 256) * (NINP / 256));
            if (F.b < Gp) {
            pg8::Gemm g{D, D, D}; pg8::DenseOrder S{nullptr, T / 256, NINP / 256, Gp, F.b, (const GAS char*)(F.ws + WS_XS), (const GAS char*)(F.ws + WS_WIN), (size_t)256 * D * 2, (size_t)256 * D * 2};
            pg8::EpiIn E{(gbf*)(F.ws + WS_QKV), (gf32*)(F.ws + WS_RS), (gbf*)(F.ws + WS_KF), (const GAS f32x4*)(F.ws + WS_TABM), (LAS float*)(F.MISC + 2048)};
            pg8::gemm_phase(ring, g, S, E); PHASE_DONE(2);
            } else cv_fill(F, args, NQ, F.ctl + CW_DONE + 2, (unsigned)Gp);
            if (BOTH(2)) GRID_BAR();
        }
        if (IN(4)) {
            { pg8::Gemm g{NINP, 512, 512};
              pg8::UpOrder S{nullptr, T / 256, F.G, F.b, (const GAS char*)((gbf*)(F.ws + WS_QKV) + 3072), (const GAS char*)((gbf*)(F.ws + WS_QKV) + 3584), (const GAS char*)(F.ws + WS_WUQ), (const GAS char*)(F.ws + WS_WUKV), (size_t)256 * NINP * 2, (size_t)256 * 512 * 2};
              pg8::EpiUp E{pg8::EpiQRope{(gbf*)(F.ws + WS_QM), (const gf32*)(F.ws + WS_RS), (const GAS f32x4*)(F.ws + WS_TABM)}, pg8::EpiKV{(gbf*)(F.ws + WS_KF), (gbf*)(F.ws + WS_VM), (const gf32*)(F.ws + WS_RS)}};
              pg8::gemm_phase(ring, g, S, E); }
            if (BOTH(4)) GRID_BAR();
        }
    } else {
        if (IN(12)) {
            const int Gp = GP_OF((T / 256) * 12);
            if (F.b < Gp) {
            pg8::Gemm g{D, D, D}; pg8::DenseOrder S{nullptr, T / 256, 12, Gp, F.b, (const GAS char*)(F.ws + WS_XS), (const GAS char*)(F.ws + WS_WQKV), (size_t)256 * D * 2, (size_t)256 * D * 2};
            pg8::EpiQKNorm E{(gbf*)(F.ws + WS_QKV), INP(16), INP(17), (const GAS f32x4*)(F.ws + WS_TABG), (LAS float*)(F.MISC + 2048)};
            pg8::gemm_phase(ring, g, S, E); PHASE_DONE(12);
            } else cv_fill(F, args, NQ, F.ctl + CW_DONE + 12, (unsigned)Gp);
            if (BOTH(12)) GRID_BAR();
        }
    }
    constexpr int pa = pb + (l ? 2 : 3);
    if (IN(pa)) {
        LAS char* alds = (LAS char*)ring;
        REP_BEGIN(pa)
        if constexpr (l == 0) {
#ifndef DBG_NO_MLA
            for (int u = F.b; u < 256 + 8; u += F.G) {
                gbf* QM = (gbf*)(F.ws + WS_QM); gbf* KF = (gbf*)(F.ws + WS_KF); gbf* VM = (gbf*)(F.ws + WS_VM); gbf* AO = (gbf*)(F.ws + WS_AO);
                const bool main = u < 256; const int h = main ? (u & 7) : (u - 256), q0 = main ? CTX + 256 * (u >> 3) : 0, NT = main ? T / 64 : CTX / 64;
                if constexpr (MLA_PP) att::attn_pp<192, 1536, 1536, 1024, (MLA_QLDS ? MLA_NQR : 0), MLA_QLA>(QM + (size_t)q0 * 1536 + h * 192, KF + h * 192, VM + h * 128, AO + (size_t)q0 * D + 1024 + h * 128, NT, alds, att::DensePol{});
                else att::attn_body<192, 1536, 1536, 1024, MLA_PIPE, MLA_SDEPTH, (MLA_QLDS ? MLA_NQR : 0)>(QM + (size_t)q0 * 1536 + h * 192, KF + h * 192, VM + h * 128, AO + (size_t)q0 * D + 1024 + h * 128, NT, alds, att::DensePol{});
                __syncthreads();
            }
#endif
#ifndef DBG_NO_NA
            for (int u = F.b; u < 256; u += F.G) {
                gbf* QKV = (gbf*)(F.ws + WS_QKV); gbf* AO = (gbf*)(F.ws + WS_AO);
                LAS float* rpbs = (LAS float*)(ring + 110592);
                const int h = u & 7, ub = u >> 3, r_unit = 4 * ub; int rlo = r_unit - 4; rlo = rlo < 0 ? 0 : (rlo > 116 ? 116 : rlo);
                { int t2 = threadIdx.x; asm volatile("" : "+v"(t2));
                  for (int idx = t2; idx < 15 * 31; idx += 512) rpbs[idx] = INP(9)[(size_t)h * 465 + idx] * 11.313708498984761f; }
                __syncthreads();
                att::NaPol pol{r_unit, rlo, rpbs};
                const int q0 = CTX + 256 * ub;
                att::attn_body<128, NINP, NINP, NINP, false, 1, MLA_NQR>(QKV + (size_t)q0 * NINP + h * 128, QKV + 1024 + h * 128, QKV + 2048 + h * 128, AO + (size_t)q0 * D + h * 128, 16, alds, pol);
                __syncthreads();
            }
#endif
        }
        constexpr int nu = l ? 512 : 8;
        for (int u = l ? F.b : (F.b >= 8 ? F.b - 8 : nu); u < nu; u += F.G) {
            gbf* QKV = (gbf*)(F.ws + WS_QKV); gbf* AO = (gbf*)(F.ws + WS_AO);
            const gbf *q, *k, *v; gbf* o; int NT; constexpr int ld = l ? 3072 : NINP;
            if constexpr (l == 0) { const int h = u; q = QKV + h * 128; k = QKV + 1024 + h * 128; v = QKV + 2048 + h * 128; o = AO + h * 128; NT = CTX / 64; }
            else { const int x = u & 7, i = u >> 8, qb = (u & 255) >> 3, kvh = x & 3, h = 4 * kvh + 2 * (x >> 2) + i;
                q = QKV + (size_t)(CTX + 256 * qb) * 3072 + h * 128; k = QKV + 2048 + kvh * 128; v = QKV + 2560 + kvh * 128; o = AO + (size_t)(CTX + 256 * qb) * D + h * 128; NT = T / 64; }
            if constexpr (l == 1 && GQA_PP) att::attn_pp<128, ld, ld, ld, GQA_NQR, QLA>(q, k, v, o, NT, alds, att::DensePol{});
            else att::attn_body<128, ld, ld, ld, true, (l ? GQA_SDEPTH : 1), (l ? GQA_NQR : 0)>(q, k, v, o, NT, alds, att::DensePol{});
            __syncthreads();
        }
        REP_END()
        if (BOTH(pa)) GRID_BAR();
    }
    constexpr int po = pb + (l ? 3 : 4);
    if (IN(po)) {
        constexpr int nM = l ? SEQ / 256 : T / 256, ro = l ? CTX : 0;
        gf32* X1 = (gf32*)(F.ws + WS_X1);
        const int Gp = GP_OF(nM * 8);
        if (F.b < Gp) {
        pg8::Gemm g{D, D, D}; pg8::DenseOrder S{nullptr, nM, 8, Gp, F.b, (const GAS char*)((gbf*)(F.ws + WS_AO) + (size_t)ro * D), (const GAS char*)(F.ws + (l ? WS_WO : WS_WOUT)), (size_t)256 * D * 2, (size_t)256 * D * 2};
        pg8::EpiResid<(l == 1)> E{X1, l ? (const gf32*)X1 : INP(2), l ? (const gf32*)X1 : INP(0) - (size_t)CTX * D, MODP(F, l, 1, 2), MODP(F, l, 0, 2), ro};
        pg8::gemm_phase(ring, g, S, E); PHASE_DONE(po);
        } else cv_fill(F, args, NQ, F.ctl + CW_DONE + po, (unsigned)Gp);
        if (BOTH(po)) GRID_BAR();
    }
    constexpr int mb = l ? 16 : 7;
    if (IN(mb)) { moe_router(F, args, l); __syncthreads(); cv_fill(F, args, l ? NQ : NQ_L0E, nullptr, 0u); if (IN(mb + 2)) GRID_BAR(); }
    if (IN(mb + 2) || IN(mb + 3)) {
        LAS int* te = (LAS int*)(F.MISC + 256);
        const GAS int* teg = (const GAS int*)(F.ws + WS_TILEE) + l * 1024;
        const int ntiles = (int)__hip_atomic_load((const gu32*)teg, RLX_AGENT);
        for (int idx = F.tid; idx < ntiles && idx < 1000; idx += 512) te[idx] = (int)__hip_atomic_load((const gu32*)teg + 16 + idx, RLX_AGENT);
        __syncthreads();
        if (IN(mb + 2)) {
            const int Gp = GP_OF(ntiles * 4);
            if (F.b < Gp) {
            pg8::Gemm g{D, D, D}; pg8::GroupedOrder<true> S{(const GAS int*)(F.ws + WS_SLOTT), ntiles, 4, Gp, F.b, (const GAS char*)(F.ws + WS_XS), (const GAS char*)(F.ws + WS_GU + (size_t)l * NEX * GU_BYTES), (size_t)0, (size_t)256 * D * 2, GU_BYTES, te};
            pg8::EpiSwiGLU E{(gbf*)(F.ws + WS_HB), (const gf32*)(F.ws + WS_SLOTW)};
            pg8::gemm_phase(ring, g, S, E); PHASE_DONE(mb + 2);
            } else cv_fill(F, args, NQ, F.ctl + CW_DONE + mb + 2, (unsigned)Gp);
            if (BOTH(mb + 2)) GRID_BAR();
        }
        if (IN(mb + 3)) {
            const int Gp = GP_OF(ntiles * 8);
            if (F.b < Gp) {
            pg8::Gemm g{DE, DE, DE}; pg8::GroupedOrder<false> S{nullptr, ntiles, 8, Gp, F.b, (const GAS char*)(F.ws + WS_HB), (const GAS char*)(F.ws + WS_DN + (size_t)l * NEX * DN_BYTES), (size_t)256 * DE * 2, (size_t)256 * DE * 2, DN_BYTES, te};
            pg8::EpiFp8RS E{F.ws + WS_YS, (const gf32*)(F.ws + WS_SLOTW)};
            pg8::gemm_phase(ring, g, S, E); PHASE_DONE(mb + 3);
            } else cv_fill(F, args, NQ, F.ctl + CW_DONE + mb + 3, (unsigned)Gp);
            if (BOTH(mb + 3)) GRID_BAR();
        }
    }
    if (IN(mb + 4)) { if constexpr (l == 0) cv_fill(F, args, NQ_L1D, nullptr, 0u); moe_combine(F, args, l); if (l == 0 && BOTH(mb + 4)) GRID_BAR(); }
}

__global__ void __launch_bounds__(NWAVES * 64, 2) fwd(Args args) {
    extern __shared__ __attribute__((aligned(16))) unsigned char lds_raw[];
    Frame F;
    F.lds = (LAS unsigned char*)lds_raw; F.MISC = (volatile LAS unsigned*)(F.lds + MISC_OFF);
    F.tid = threadIdx.x; F.lane = F.tid & 63; F.wave = __builtin_amdgcn_readfirstlane(F.tid >> 6); F.b = blockIdx.x; F.G = gridDim.x;
    F.ws = (GAS unsigned char*)args.ws; F.ctl = (gu32*)(F.ws + WS_CTL); F.out = (gf32*)args.out;
    for (int u = F.tid; u < MISC_BYTES / 4; u += NWAVES * 64) F.MISC[u] = 0u;
    __syncthreads();
    XcdBarrier bar; bar.bar = (unsigned*)args.ws + CW_BAR; bar.x = 0; bar.st = nullptr;
#if MK_ONE_LAUNCH
    bar = xcd_barrier_post((unsigned*)args.ws + CW_BAR, F.MISC);
#endif
    const int lo = args.ph_lo, hi = args.ph_hi;
    if (IN(0)) { REP_BEGIN(0) p0_prologue(F, args); REP_END() if (BOTH(0)) GRID_BAR(); }
    if (IN(1)) { p1_prenorm0(F, args); if (BOTH(1)) GRID_BAR(); }
    layer_phases<0>(F, args, bar, lo, hi);
    layer_phases<1>(F, args, bar, lo, hi);
}
#undef IN
#undef BOTH

extern "C" void kernel_launch(void* const* d_in, const int* in_sizes, int n_in, void* d_out, int out_size, void* d_ws, size_t ws_size, hipStream_t stream) {
    static int grid = 0;
    if (grid == 0) {
        if (n_in != 28 || out_size != SEQ * D || ws_size < WS_END) { fprintf(stderr, "kernel_launch: shape mismatch n_in %d out %d ws %zu (need %zu)\n", n_in, out_size, ws_size, (size_t)WS_END); grid = -1; return; }
        int dev = 0, cus = 0, per_cu = 0;
        if (hipGetDevice(&dev) != hipSuccess || hipDeviceGetAttribute(&cus, hipDeviceAttributeMultiprocessorCount, dev) != hipSuccess) { grid = -1; return; }
        if (hipFuncSetAttribute((const void*)fwd, hipFuncAttributeMaxDynamicSharedMemorySize, LDS_BYTES) != hipSuccess) { fprintf(stderr, "kernel_launch: hipFuncSetAttribute failed\n"); grid = -1; return; }
        if (hipOccupancyMaxActiveBlocksPerMultiprocessor(&per_cu, (const void*)fwd, NWAVES * 64, LDS_BYTES) != hipSuccess || per_cu < 1) fprintf(stderr, "kernel_launch: occupancy query reports %d\n", per_cu);
        (void)hipGetLastError();
        grid = cus;
    }
    if (grid < 0) return;
    if (hipMemsetAsync((char*)d_ws + WS_CTL, 0, CTL_ZERO_BYTES, stream) != hipSuccess) return;
    Args a{};
    for (int i = 0; i < 28; ++i) a.in[i] = (const float*)d_in[i];
    a.out = (float*)d_out; a.ws = (unsigned char*)d_ws;
#if MK_ONE_LAUNCH
    a.ph_lo = 0; a.ph_hi = NPHASES;
    hipLaunchKernelGGL(fwd, dim3(grid), dim3(NWAVES * 64), LDS_BYTES, stream, a);
#else
    for (int p = 0; p < NPHASES; ++p) { a.ph_lo = p; a.ph_hi = p + 1; hipLaunchKernelGGL(fwd, dim3(grid), dim3(NWAVES * 64), LDS_BYTES, stream, a); }
#endif
}
```

```cpp
#include <hip/hip_runtime.h>
#include <cstdio>
#include <cstdint>

#ifndef CV_KADJ
#define CV_KADJ 1
#endif
#ifndef ACCI
#define ACCI 1
#endif
#define QSC128 (0.088388347648318440f * 1.4426950408889634f)
#define QSC192 (0.072168783648703220f * 1.4426950408889634f)

#ifndef CV_DEEP_DRAIN
#define CV_DEEP_DRAIN 1
#endif
#ifndef MLA_NQR
#ifndef ATT_EARLY
#define ATT_EARLY 1
#endif
#define MLA_NQR 6
#endif
#ifndef MK_ONE_LAUNCH
#define MK_ONE_LAUNCH 1
#endif

#define LAS __attribute__((address_space(3)))
#define GAS __attribute__((address_space(1)))
typedef unsigned short bf16_t;
typedef short bf16x8 __attribute__((ext_vector_type(8)));
typedef short s16x4 __attribute__((ext_vector_type(4)));
typedef float f32x2 __attribute__((ext_vector_type(2)));
typedef float f32x4 __attribute__((ext_vector_type(4)));
typedef float f32x16 __attribute__((ext_vector_type(16)));
typedef unsigned u32x2 __attribute__((ext_vector_type(2)));
typedef unsigned u32x4 __attribute__((ext_vector_type(4)));
typedef GAS unsigned gu32;
typedef GAS float gf32;
typedef GAS bf16_t gbf;

constexpr int D = 2048, SEQ = 8192, CTX = 256, T = CTX + SEQ;
constexpr int NE = 64, TOPK = 8, DE = 512;
constexpr int NIN = 4160, NINP = 4352;
constexpr float EPS = 1e-6f;
constexpr int PMAX = T + T * TOPK + NE * 256;
constexpr int NEX = NE + 1;

constexpr size_t al256(size_t x) { return (x + 255) / 256 * 256; }
constexpr size_t WS_CTL = 0, CTL_ZERO_BYTES = 65536;
constexpr int CW_BAR = 0, CW_CNT = 4096, CW_CUR = 4096 + 128, CW_ARR = 4096 + 640;
constexpr size_t WS_MOD = 1u << 20;
constexpr size_t WS_PART = WS_MOD + al256(2 * 2 * 12288 * 4);
constexpr size_t WS_TABM = WS_PART + al256(2 * 8 * 2 * 12288 * 4);
constexpr size_t WS_TABG = WS_TABM + al256((size_t)T * 32 * 8);
constexpr size_t WS_RS = WS_TABG + al256((size_t)T * 64 * 8);
constexpr size_t WS_TOKE = WS_RS + al256((size_t)T * 4 * 4);
constexpr size_t WS_TOKW = WS_TOKE + al256((size_t)T * 8 * 4);
constexpr size_t WS_TOKS = WS_TOKW + al256((size_t)T * 8 * 4);
constexpr size_t WS_SLOTW = WS_TOKS + al256((size_t)T * 8 * 4);
constexpr size_t WS_SLOTT = WS_SLOTW + al256((size_t)PMAX * 4);
constexpr size_t WS_TILEE = WS_SLOTT + al256((size_t)PMAX * 4);
constexpr size_t WS_WRT = WS_TILEE + al256(2 * 1024 * 4);
constexpr size_t WS_WIN = WS_WRT + al256((size_t)2 * 2 * NE * D * 2);
constexpr size_t WS_WUQ = WS_WIN + al256((size_t)NINP * D * 2);
constexpr size_t WS_WUKV = WS_WUQ + al256((size_t)1536 * 512 * 2);
constexpr size_t WS_WOUT = WS_WUKV + al256((size_t)2048 * 512 * 2);
constexpr size_t WS_WQKV = WS_WOUT + al256((size_t)D * D * 2);
constexpr size_t WS_WO = WS_WQKV + al256((size_t)3072 * D * 2);
constexpr size_t GU_BYTES = (size_t)1024 * D * 2, DN_BYTES = (size_t)D * DE * 2;
constexpr size_t WS_GU = WS_WO + al256((size_t)D * D * 2);
constexpr size_t WS_DN = WS_GU + (size_t)2 * NEX * GU_BYTES;
constexpr size_t WS_X1 = WS_DN + (size_t)2 * NEX * DN_BYTES;
constexpr size_t WS_XS = WS_X1 + (size_t)T * D * 4;
constexpr size_t WS_QKV = WS_XS + (size_t)T * D * 2;
constexpr size_t WS_QM = WS_QKV + (size_t)T * NINP * 2;
constexpr size_t WS_KF = WS_QM + (size_t)T * 1536 * 2;
constexpr size_t WS_VM = WS_KF + (size_t)T * 1536 * 2;
constexpr size_t WS_AO = WS_VM + (size_t)T * 1024 * 2;
constexpr size_t WS_HB = WS_AO + (size_t)T * D * 2;
constexpr size_t WS_YS = WS_HB + (size_t)PMAX * DE * 2;
constexpr size_t WS_END = WS_YS + (size_t)PMAX * D;

constexpr int RING_OFF = 0, RING_BYTES = 139264, MISC_OFF = RING_BYTES, MISC_BYTES = 16384, LDS_BYTES = RING_BYTES + MISC_BYTES;

__device__ __forceinline__ float bf2f_lo(unsigned w) { return __uint_as_float(w << 16); }
__device__ __forceinline__ float bf2f_hi(unsigned w) { return __uint_as_float(w & 0xffff0000u); }
__device__ __forceinline__ unsigned f2bf(float f) { unsigned u = __float_as_uint(f); return (u + 0x7fffu + ((u >> 16) & 1u)) >> 16; }
__device__ __forceinline__ unsigned cvt_pk_bf16(float lo, float hi) { unsigned r; asm volatile("v_cvt_pk_bf16_f32 %0, %1, %2" : "=v"(r) : "v"(lo), "v"(hi)); return r; }
__device__ __forceinline__ unsigned pk2(float lo, float hi) { return cvt_pk_bf16(lo, hi); }
__device__ __forceinline__ void x1_ld8(const gbf* p, f32x4& a, f32x4& b) { const u32x4 w = *(const GAS u32x4*)p; a = (f32x4){bf2f_lo(w[0]), bf2f_hi(w[0]), bf2f_lo(w[1]), bf2f_hi(w[1])}; b = (f32x4){bf2f_lo(w[2]), bf2f_hi(w[2]), bf2f_lo(w[3]), bf2f_hi(w[3])}; }
__device__ __forceinline__ f32x4 x1_ld4(const gbf* p) { const u32x2 w = *(const GAS u32x2*)p; return (f32x4){bf2f_lo(w[0]), bf2f_hi(w[0]), bf2f_lo(w[1]), bf2f_hi(w[1])}; }
__device__ __forceinline__ void x1_st4(gbf* p, f32x4 v) { *(GAS u32x2*)p = (u32x2){pk2(v[0], v[1]), pk2(v[2], v[3])}; }
__device__ __forceinline__ float wave_sum(float v) {
#pragma unroll
    for (int o = 1; o < 64; o <<= 1) v += __shfl_xor(v, o);
    return v;
}
#define LDS_WAIT() asm volatile("s_waitcnt lgkmcnt(0)" ::: "memory")
#define VM_WAIT() asm volatile("s_waitcnt vmcnt(0)" ::: "memory")
#define RLX_AGENT __ATOMIC_RELAXED, __HIP_MEMORY_SCOPE_AGENT

namespace pg8 {
constexpr int BM = 256, BK = 64, HALF = 128, HTB = HALF * BK * 2, STAGE_BYTES = 8 * HTB, NXCD = 8, WGM = 8;
__host__ __device__ __forceinline__ int lds_byte(int r, int c) { const int st = (r >> 4) * 2 + (c >> 5), rr = r & 15, cc = c & 31, ob = rr * 64 + cc * 2; return st * 1024 + (ob ^ (((ob >> 9) & 1) << 5)); }
__host__ __device__ __forceinline__ void stage_rc(int b, int& R, int& C) { const int st = b / 1024, sb = b % 1024, swz = sb ^ (((sb >> 9) & 1) << 5); R = (st >> 1) * 16 + swz / 64; C = (st & 1) * 32 + (swz % 64) / 2; }
__host__ __device__ __forceinline__ int perm32(int rho) { const int n = rho >> 4, i = rho & 15; return 8 * (i >> 2) + 4 * n + (i & 3); }

struct Unit { int pm, pn; const GAS char* a; const GAS char* b; int half; };
struct Gemm { int lda, ldb, K; };

__device__ __forceinline__ bool tile_of(long L, int nM, int nN, int& pm, int& pn) {
    const int nwg = nM * nN; if (L >= nwg) return false;
    int wgid = (int)L; { const int q = nwg / NXCD, r = nwg % NXCD, xcd = wgid % NXCD, off = wgid / NXCD; wgid = (xcd < r ? xcd * (q + 1) : r * (q + 1) + (xcd - r) * q) + off; }
    const int nig = WGM * nN, gid = wgid / nig, fm = gid * WGM, gsz = (nM - fm) < WGM ? (nM - fm) : WGM;
    pm = fm + ((wgid % nig) % gsz); pn = (wgid % nig) / gsz; return true;
}
struct DenseOrder {
    static constexpr bool GATHER = false; const GAS int* rowtab;
    int nM, nN, G, c; const GAS char* A; const GAS char* B; size_t tA, tB;
    __device__ __forceinline__ bool next(int i, Unit& u) const { if (!tile_of((long)i * G + c, nM, nN, u.pm, u.pn)) return false; u.a = A + (size_t)u.pm * tA; u.b = B + (size_t)u.pn * tB; u.half = 0; return true; }
};
struct UpOrder {
    static constexpr bool GATHER = false; const GAS int* rowtab;
    int nM, G, c; const GAS char* Aq; const GAS char* Akv; const GAS char* Bq; const GAS char* Bkv; size_t tA, tB;
    __device__ __forceinline__ bool next(int i, Unit& u) const { long L = (long)i * G + c; const int nq = nM * 6;
        if (L < nq) { if (!tile_of(L, nM, 6, u.pm, u.pn)) return false; u.a = Aq + (size_t)u.pm * tA; u.b = Bq + (size_t)u.pn * tB; u.half = 0; return true; }
        L -= nq; if (!tile_of(L, nM, 8, u.pm, u.pn)) return false; u.a = Akv + (size_t)u.pm * tA; u.b = Bkv + (size_t)u.pn * tB; u.half = 1; return true; }
};
template <bool GATHER_>
struct GroupedOrder {
    static constexpr bool GATHER = GATHER_; const GAS int* rowtab;
    int nM, nN, G, c; const GAS char* A; const GAS char* B; size_t tA, tB, eB; const LAS int* te;
    __device__ __forceinline__ bool next(int i, Unit& u) const { if (!tile_of((long)i * G + c, nM, nN, u.pm, u.pn)) return false; u.a = A + (size_t)u.pm * tA; u.b = B + (size_t)te[u.pm] * eB + (size_t)u.pn * tB; u.half = 0; return true; }
};

struct EpiBf16RS {
    static constexpr bool PERM = true;
    gbf* O; int ldc; const gf32* rscale;
    __device__ __forceinline__ void operator()(const f32x4 (&acc)[2][2][4][2], const Unit& u, int wr, int wc, int fr, int fq) const {
        const int row0 = u.pm * BM + wr * 64 + fr, col0 = u.pn * BM + wc * 32 + 8 * fq;
#pragma unroll
        for (int ai = 0; ai < 2; ++ai)
#pragma unroll
            for (int m = 0; m < 4; ++m) { const int row = row0 + ai * HALF + m * 16; const float s = rscale ? rscale[row] : 1.f; gbf* rowp = O + (size_t)row * ldc + col0;
#pragma unroll
                for (int bj = 0; bj < 2; ++bj) { const f32x4 v0 = acc[ai][bj][m][0] * s, v1 = acc[ai][bj][m][1] * s;
                    u32x4 w; w.x = cvt_pk_bf16(v0[0], v0[1]); w.y = cvt_pk_bf16(v0[2], v0[3]); w.z = cvt_pk_bf16(v1[0], v1[1]); w.w = cvt_pk_bf16(v1[2], v1[3]);
                    *(GAS u32x4*)(rowp + bj * HALF) = w; } }
    }
};
constexpr float YS_SCALE = 16.f;
struct EpiFp8RS {
    static constexpr bool PERM = true;
    GAS unsigned char* O; const gf32* rscale;
    __device__ __forceinline__ void operator()(const f32x4 (&acc)[2][2][4][2], const Unit& u, int wr, int wc, int fr, int fq) const {
        const int row0 = u.pm * BM + wr * 64 + fr, col0 = u.pn * BM + wc * 64 + 16 * fq;
#pragma unroll
        for (int ai = 0; ai < 2; ++ai)
#pragma unroll
            for (int m = 0; m < 4; ++m) { const int row = row0 + ai * HALF + m * 16; const float s = YS_SCALE; u32x4 w;
#pragma unroll
                for (int bj = 0; bj < 2; ++bj)
#pragma unroll
                    for (int n = 0; n < 2; ++n) { f32x4 v = acc[ai][bj][m][n] * s;
#pragma unroll
                        for (int j = 0; j < 4; ++j) v[j] = __builtin_amdgcn_fmed3f(v[j], -448.f, 448.f);
                        int p = __builtin_amdgcn_cvt_pk_fp8_f32(v[0], v[1], 0, false); p = __builtin_amdgcn_cvt_pk_fp8_f32(v[2], v[3], p, true); w[bj * 2 + n] = (unsigned)p; }
                *(GAS u32x4*)(O + (size_t)row * D + col0) = w; }
    }
};
struct EpiQRope {
    static constexpr bool PERM = true;
    gbf* O; const gf32* rscale; const GAS f32x4* tab;
    __device__ __forceinline__ void operator()(const f32x4 (&acc)[2][2][4][2], const Unit& u, int wr, int wc, int fr, int fq) const {
        const int row0 = u.pm * BM + wr * 64 + fr, col0 = u.pn * BM + wc * 32 + 8 * fq;
#pragma unroll
        for (int ai = 0; ai < 2; ++ai)
#pragma unroll
            for (int m = 0; m < 4; ++m) { const int row = row0 + ai * HALF + m * 16; const f32x2 sq = *(const GAS f32x2*)(rscale + 4 * row); const float s = rsqrtf((sq[0] + sq[1]) * (1.f / 512.f) + EPS) * (ACCI ? QSC192 : 1.f); gbf* rowp = O + (size_t)row * 1536 + col0;
#pragma unroll
                for (int bj = 0; bj < 2; ++bj) { f32x4 v0 = acc[ai][bj][m][0] * s, v1 = acc[ai][bj][m][1] * s;
                    const int c = col0 + bj * HALF, j = c % 192;
                    if (j >= 128) { const int i0 = (j - 128) >> 1;
                        const f32x4 t0 = tab[(size_t)row * 16 + (i0 >> 1)], t1 = tab[(size_t)row * 16 + (i0 >> 1) + 1];
                        const f32x4 a = v0, b = v1;
                        v0[0] = a[0] * t0[0] - a[1] * t0[1]; v0[1] = a[0] * t0[1] + a[1] * t0[0]; v0[2] = a[2] * t0[2] - a[3] * t0[3]; v0[3] = a[2] * t0[3] + a[3] * t0[2];
                        v1[0] = b[0] * t1[0] - b[1] * t1[1]; v1[1] = b[0] * t1[1] + b[1] * t1[0]; v1[2] = b[2] * t1[2] - b[3] * t1[3]; v1[3] = b[2] * t1[3] + b[3] * t1[2]; }
                    u32x4 w; w.x = cvt_pk_bf16(v0[0], v0[1]); w.y = cvt_pk_bf16(v0[2], v0[3]); w.z = cvt_pk_bf16(v1[0], v1[1]); w.w = cvt_pk_bf16(v1[2], v1[3]);
                    *(GAS u32x4*)(rowp + bj * HALF) = w; } }
    }
};
struct EpiIn {
    static constexpr bool PERM = true;
    gbf* O; gf32* ssq; gbf* KF; const GAS f32x4* tab; LAS float* red;
    __device__ __forceinline__ void operator()(const f32x4 (&acc)[2][2][4][2], const Unit& u, int wr, int wc, int fr, int fq) const {
        const int row0 = u.pm * BM + wr * 64 + fr, col0 = u.pn * BM + wc * 32 + 8 * fq;
#pragma unroll
        for (int ai = 0; ai < 2; ++ai)
#pragma unroll
            for (int m = 0; m < 4; ++m) { gbf* rowp = O + (size_t)(row0 + ai * HALF + m * 16) * NINP + col0;
#pragma unroll
                for (int bj = 0; bj < 2; ++bj) { const f32x4 v0 = acc[ai][bj][m][0], v1 = acc[ai][bj][m][1];
                    u32x4 w; w.x = cvt_pk_bf16(v0[0], v0[1]); w.y = cvt_pk_bf16(v0[2], v0[3]); w.z = cvt_pk_bf16(v1[0], v1[1]); w.w = cvt_pk_bf16(v1[2], v1[3]);
                    *(GAS u32x4*)(rowp + bj * HALF) = w; } }
        if (u.pn >= 12 && u.pn < 16) {
#pragma unroll
            for (int ai = 0; ai < 2; ++ai)
#pragma unroll
                for (int m = 0; m < 4; ++m) { float ss = 0.f;
#pragma unroll
                    for (int bj = 0; bj < 2; ++bj)
#pragma unroll
                        for (int n = 0; n < 2; ++n) { const f32x4 a = acc[ai][bj][m][n]; ss += (a[0] * a[0] + a[1] * a[1]) + (a[2] * a[2] + a[3] * a[3]); }
                    ss += __shfl_xor(ss, 16); ss += __shfl_xor(ss, 32);
                    if (fq == 0) red[(ai * HALF + wr * 64 + m * 16 + fr) * 4 + wc] = ss; }
            asm volatile("s_waitcnt lgkmcnt(0)" ::: "memory"); __builtin_amdgcn_s_barrier(); asm volatile("" ::: "memory");
            if (wc == 0 && fq == 0) {
#pragma unroll
                for (int ai = 0; ai < 2; ++ai)
#pragma unroll
                    for (int m = 0; m < 4; ++m) { const int rl = ai * HALF + wr * 64 + m * 16 + fr; const f32x4 p = *(const LAS f32x4*)(red + rl * 4);
                        ssq[(size_t)(u.pm * BM + rl) * 4 + (u.pn - 12)] = (p[0] + p[1]) + (p[2] + p[3]); } }
        } else if (u.pn == 16 && wc < 2) {
            const int cih = wc * 32 + 8 * fq;
#pragma unroll
            for (int ai = 0; ai < 2; ++ai)
#pragma unroll
                for (int m = 0; m < 4; ++m) { const int row = row0 + ai * HALF + m * 16; const f32x4 a = acc[ai][0][m][0], b = acc[ai][0][m][1];
                    const f32x4 t0 = tab[(size_t)row * 16 + (cih >> 2)], t1 = tab[(size_t)row * 16 + (cih >> 2) + 1];
                    u32x4 w;
                    w.x = cvt_pk_bf16(a[0] * t0[0] - a[1] * t0[1], a[0] * t0[1] + a[1] * t0[0]); w.y = cvt_pk_bf16(a[2] * t0[2] - a[3] * t0[3], a[2] * t0[3] + a[3] * t0[2]);
                    w.z = cvt_pk_bf16(b[0] * t1[0] - b[1] * t1[1], b[0] * t1[1] + b[1] * t1[0]); w.w = cvt_pk_bf16(b[2] * t1[2] - b[3] * t1[3], b[2] * t1[3] + b[3] * t1[2]);
#pragma unroll
                    for (int h = 0; h < 8; ++h) *(GAS u32x4*)(KF + (size_t)row * 1536 + h * 192 + 128 + cih) = w; }
        }
    }
};
struct EpiQKNorm {
    static constexpr bool PERM = true;
    gbf* O; const gf32* qg; const gf32* kg; const GAS f32x4* tab; LAS float* red;
    __device__ __forceinline__ void operator()(const f32x4 (&acc)[2][2][4][2], const Unit& u, int wr, int wc, int fr, int fq) const {
        const int row0 = u.pm * BM + wr * 64 + fr, col0 = u.pn * BM + wc * 32 + 8 * fq;
        if (u.pn >= 10) {
#pragma unroll
            for (int ai = 0; ai < 2; ++ai)
#pragma unroll
                for (int m = 0; m < 4; ++m) { gbf* rowp = O + (size_t)(row0 + ai * HALF + m * 16) * 3072 + col0;
#pragma unroll
                    for (int bj = 0; bj < 2; ++bj) { const f32x4 v0 = acc[ai][bj][m][0], v1 = acc[ai][bj][m][1];
                        u32x4 w; w.x = cvt_pk_bf16(v0[0], v0[1]); w.y = cvt_pk_bf16(v0[2], v0[3]); w.z = cvt_pk_bf16(v1[0], v1[1]); w.w = cvt_pk_bf16(v1[2], v1[3]);
                        *(GAS u32x4*)(rowp + bj * HALF) = w; } }
            return; }
#pragma unroll
        for (int ai = 0; ai < 2; ++ai)
#pragma unroll
            for (int m = 0; m < 4; ++m)
#pragma unroll
                for (int bj = 0; bj < 2; ++bj) { const f32x4 a = acc[ai][bj][m][0], b = acc[ai][bj][m][1];
                    float ss = (a[0] * a[0] + a[1] * a[1]) + (a[2] * a[2] + a[3] * a[3]) + (b[0] * b[0] + b[1] * b[1]) + (b[2] * b[2] + b[3] * b[3]);
                    ss += __shfl_xor(ss, 16); ss += __shfl_xor(ss, 32);
                    if (fq == 0) red[((ai * HALF + wr * 64 + m * 16 + fr) * 2 + bj) * 4 + wc] = ss; }
        asm volatile("s_waitcnt lgkmcnt(0)" ::: "memory"); __builtin_amdgcn_s_barrier(); asm volatile("" ::: "memory");
        const int cih = wc * 32 + 8 * fq;
        const gf32* g = (u.pn < 8 ? qg : kg) + cih;
        const f32x4 g0 = *(const GAS f32x4*)g, g1 = *(const GAS f32x4*)(g + 4);
#pragma unroll
        for (int ai = 0; ai < 2; ++ai)
#pragma unroll
            for (int m = 0; m < 4; ++m) { const int rl = ai * HALF + wr * 64 + m * 16 + fr, row = u.pm * BM + rl; gbf* rowp = O + (size_t)row * 3072 + col0;
                const f32x4 t0 = tab[(size_t)row * 32 + (cih >> 2)], t1 = tab[(size_t)row * 32 + (cih >> 2) + 1];
#pragma unroll
                for (int bj = 0; bj < 2; ++bj) { const f32x4 p = *(const LAS f32x4*)(red + (rl * 2 + bj) * 4);
                    const float rs = rsqrtf(((p[0] + p[1]) + (p[2] + p[3])) * (1.f / 128.f) + EPS) * ((ACCI && u.pn < 8) ? QSC128 : 1.f);
                    const f32x4 a = acc[ai][bj][m][0] * rs * g0, b = acc[ai][bj][m][1] * rs * g1;
                    u32x4 w;
                    w.x = cvt_pk_bf16(a[0] * t0[0] - a[1] * t0[1], a[0] * t0[1] + a[1] * t0[0]); w.y = cvt_pk_bf16(a[2] * t0[2] - a[3] * t0[3], a[2] * t0[3] + a[3] * t0[2]);
                    w.z = cvt_pk_bf16(b[0] * t1[0] - b[1] * t1[1], b[0] * t1[1] + b[1] * t1[0]); w.w = cvt_pk_bf16(b[2] * t1[2] - b[3] * t1[3], b[2] * t1[3] + b[3] * t1[2]);
                    *(GAS u32x4*)(rowp + bj * HALF) = w; } }
    }
};
struct EpiKV {
    static constexpr bool PERM = true;
    gbf* KF; gbf* VM; const gf32* rscale;
    __device__ __forceinline__ void operator()(const f32x4 (&acc)[2][2][4][2], const Unit& u, int wr, int wc, int fr, int fq) const {
        const int row0 = u.pm * BM + wr * 64 + fr, j0 = wc * 32 + 8 * fq;
#pragma unroll
        for (int ai = 0; ai < 2; ++ai)
#pragma unroll
            for (int m = 0; m < 4; ++m) { const int row = row0 + ai * HALF + m * 16; const f32x2 sq = *(const GAS f32x2*)(rscale + 4 * row + 2); const float s = rsqrtf((sq[0] + sq[1]) * (1.f / 512.f) + EPS);
#pragma unroll
                for (int bj = 0; bj < 2; ++bj) { const f32x4 v0 = acc[ai][bj][m][0] * s, v1 = acc[ai][bj][m][1] * s;
                    u32x4 w; w.x = cvt_pk_bf16(v0[0], v0[1]); w.y = cvt_pk_bf16(v0[2], v0[3]); w.z = cvt_pk_bf16(v1[0], v1[1]); w.w = cvt_pk_bf16(v1[2], v1[3]);
                    gbf* p = bj == 0 ? KF + (size_t)row * 1536 + u.pn * 192 + j0 : VM + (size_t)row * 1024 + u.pn * 128 + j0;
                    *(GAS u32x4*)p = w; } }
    }
};
template <bool XIN_BF>
struct EpiResid {
    static constexpr bool PERM = false;
    gf32* X1; const gf32* xin_ctx; const gf32* xin_lat; const gf32* gate_ctx; const gf32* gate_lat; int row_off;
    __device__ __forceinline__ void operator()(const f32x4 (&acc)[2][2][4][2], const Unit& u, int wr, int wc, int fr, int fq) const {
        const int row0 = u.pm * BM + wr * 64 + fr + row_off, col0 = u.pn * BM + wc * 32 + 4 * fq;
        const bool isctx = (u.pm * BM + row_off) < CTX;
        const gf32* gate = isctx ? gate_ctx : gate_lat; const gf32* xin = isctx ? xin_ctx : xin_lat;
        f32x4 gv[2][2];
#pragma unroll
        for (int bj = 0; bj < 2; ++bj)
#pragma unroll
            for (int n = 0; n < 2; ++n) gv[bj][n] = *(const GAS f32x4*)(gate + col0 + bj * HALF + n * 16);
#pragma unroll
        for (int ai = 0; ai < 2; ++ai)
#pragma unroll
            for (int m = 0; m < 4; ++m) { const size_t ro = (size_t)(row0 + ai * HALF + m * 16) * D + col0;
#pragma unroll
                for (int bj = 0; bj < 2; ++bj)
#pragma unroll
                    for (int n = 0; n < 2; ++n) { f32x4 xv; if constexpr (XIN_BF) xv = x1_ld4((const gbf*)xin + ro + bj * HALF + n * 16); else xv = *(const GAS f32x4*)(xin + ro + bj * HALF + n * 16);
                        x1_st4((gbf*)X1 + ro + bj * HALF + n * 16, xv + gv[bj][n] * acc[ai][bj][m][n]); } }
    }
};
struct EpiSwiGLU {
    static constexpr bool PERM = true;
    gbf* H; const gf32* rscale;
    __device__ __forceinline__ void operator()(const f32x4 (&acc)[2][2][4][2], const Unit& u, int wr, int wc, int fr, int fq) const {
        const int row0 = u.pm * BM + wr * 64 + fr, col0 = u.pn * 128 + wc * 32 + 8 * fq;
#pragma unroll
        for (int ai = 0; ai < 2; ++ai)
#pragma unroll
            for (int m = 0; m < 4; ++m) { const int row = row0 + ai * HALF + m * 16; float h[8]; const float rs = rscale[row];
#pragma unroll
                for (int n = 0; n < 2; ++n)
#pragma unroll
                    for (int j = 0; j < 4; ++j) { const float g = acc[ai][0][m][n][j], up = acc[ai][1][m][n][j]; h[n * 4 + j] = g * __builtin_amdgcn_rcpf(1.f + __expf(-g)) * (up * rs); }
                u32x4 w; w.x = cvt_pk_bf16(h[0], h[1]); w.y = cvt_pk_bf16(h[2], h[3]); w.z = cvt_pk_bf16(h[4], h[5]); w.w = cvt_pk_bf16(h[6], h[7]);
                *(GAS u32x4*)(H + (size_t)row * DE + col0) = w; }
    }
};

struct EpiUp {
    static constexpr bool PERM = true; EpiQRope q; EpiKV kv;
    __device__ __forceinline__ void operator()(const f32x4 (&acc)[2][2][4][2], const Unit& u, int wr, int wc, int fr, int fq) const { if (u.half == 0) q(acc, u, wr, wc, fr, fq); else kv(acc, u, wr, wc, fr, fq); }
};
template <class Epi, class Sched>
__device__ __forceinline__ void gemm_phase(LAS unsigned char* lds, const Gemm g, const Sched& S, const Epi& E) {
    int tid_ = threadIdx.x; asm volatile("" : "+v"(tid_));
    const int tid = tid_, wid = __builtin_amdgcn_readfirstlane(tid >> 6), lane = tid & 63, wr = wid >> 2, wc = wid & 3, fr = lane & 15, fq = lane >> 4;
    const int K = g.K, nt = K / BK;
    unsigned voA[2][2], nvoA[2][2], voffB[2]; int RA[2], CA[2];
#pragma unroll
    for (int i = 0; i < 2; ++i) { int R, C; stage_rc(tid * 16 + i * 8192, R, C); const int Rb = Epi::PERM ? ((R & ~31) + perm32(R & 31)) : R; RA[i] = R; CA[i] = C;
        voA[0][i] = (unsigned)(R * g.lda + C) * 2u; voA[1][i] = (unsigned)((R + HALF) * g.lda + C) * 2u; voffB[i] = (unsigned)(Rb * g.ldb + C) * 2u; }
    const size_t kstep = (size_t)(BK * 2);
    const size_t hstepB = (size_t)HALF * g.ldb * 2;
    const unsigned ldsw = (unsigned)wid * 1024u;
    const int aoff = lds_byte(wr * 64 + fr, fq * 8), boff = lds_byte(wc * 32 + fr, fq * 8);
#define PG8_SA(b, h) (((b) * 2 + (h)) * HTB)
#define PG8_SB(b, h) ((4 + (b) * 2 + (h)) * HTB)
#define PG8_STAGE(bufoff, gbase, voff) do { _Pragma("unroll") for (int _i = 0; _i < 2; ++_i) \
        __builtin_amdgcn_global_load_lds((const GAS unsigned*)((gbase) + (voff)[_i]), (LAS unsigned*)(lds + (bufoff) + ldsw + _i * 8192), 16, 0, 0); } while (0)
#define PG8_GATHER(u, dst) do { _Pragma("unroll") for (int _h = 0; _h < 2; ++_h) _Pragma("unroll") for (int _i = 0; _i < 2; ++_i) \
        dst[_h][_i] = (unsigned)(S.rowtab[(u).pm * BM + _h * HALF + RA[_i]] * g.lda + CA[_i]) * 2u; } while (0)
#define PG8_LDA(dst, b, h) do { _Pragma("unroll") for (int m = 0; m < 4; ++m) _Pragma("unroll") for (int k = 0; k < 2; ++k) dst[m][k] = *(const LAS bf16x8*)(lds + PG8_SA(b, h) + aoff + m * 2048 + k * 1024); } while (0)
#define PG8_LDB(dst, b, h) do { _Pragma("unroll") for (int n = 0; n < 2; ++n) _Pragma("unroll") for (int k = 0; k < 2; ++k) dst[n][k] = *(const LAS bf16x8*)(lds + PG8_SB(b, h) + boff + n * 2048 + k * 1024); } while (0)
#define PG8_MMA(ai, bj, At, Bt) do { __builtin_amdgcn_s_setprio(1); _Pragma("unroll") for (int m = 0; m < 4; ++m) _Pragma("unroll") for (int n = 0; n < 2; ++n) _Pragma("unroll") for (int k = 0; k < 2; ++k) \
        acc[ai][bj][m][n] = __builtin_amdgcn_mfma_f32_16x16x32_bf16(Bt[n][k], At[m][k], acc[ai][bj][m][n], 0, 0, 0); __builtin_amdgcn_s_setprio(0); } while (0)
#define PG8_WAIT_V(n) asm volatile("s_waitcnt vmcnt(" #n ")" ::: "memory")
#define PG8_WAIT_L(n) asm volatile("s_waitcnt lgkmcnt(" #n ")" ::: "memory")
#define PG8_BAR __builtin_amdgcn_s_barrier()
#define PG8_SCHED __builtin_amdgcn_sched_barrier(0)
    Unit cur, nxt; int ui = 0;
    if (!S.next(0, cur)) return;
    f32x4 acc[2][2][4][2];
#pragma unroll
    for (int a = 0; a < 2; ++a)
#pragma unroll
        for (int b = 0; b < 2; ++b)
#pragma unroll
            for (int m = 0; m < 4; ++m)
#pragma unroll
                for (int n = 0; n < 2; ++n) acc[a][b][m][n] = (f32x4){0.f, 0.f, 0.f, 0.f};
    bf16x8 At[4][2], B0[2][2], B1[2][2];
    const GAS char* cA = cur.a; const GAS char* cB = cur.b;
    if constexpr (Sched::GATHER) PG8_GATHER(cur, voA);
    PG8_STAGE(PG8_SB(0, 0), cB, voffB); PG8_STAGE(PG8_SB(0, 1), cB + hstepB, voffB); PG8_STAGE(PG8_SA(0, 0), cA, voA[0]); PG8_STAGE(PG8_SA(0, 1), cA, voA[1]);
    if (wr == 1) PG8_BAR;
    PG8_WAIT_V(2); PG8_BAR;
    PG8_STAGE(PG8_SB(1, 0), cB + kstep, voffB); PG8_STAGE(PG8_SA(1, 0), cA + kstep, voA[0]); PG8_STAGE(PG8_SB(1, 1), cB + hstepB + kstep, voffB);
    PG8_WAIT_V(6); PG8_BAR;
    for (;;) {
        const bool has_next = S.next(ui + 1, nxt);
        const GAS char* nA = has_next ? nxt.a : cA; const GAS char* nB = has_next ? nxt.b : cB;
        if constexpr (Sched::GATHER) { if (has_next) PG8_GATHER(nxt, nvoA); else {
#pragma unroll
            for (int _h = 0; _h < 2; ++_h)
#pragma unroll
                for (int _i = 0; _i < 2; ++_i) nvoA[_h][_i] = voA[_h][_i]; } }
        for (int t = 0; t < nt; t += 2) {
            const bool last = (t == nt - 2);
            const GAS char* a1 = cA + (size_t)(t + 1) * kstep;
            const GAS char* a2 = last ? nA : cA + (size_t)(t + 2) * kstep; const GAS char* b2 = last ? nB : cB + (size_t)(t + 2) * kstep;
            const GAS char* a3 = a2 + kstep; const GAS char* b3 = b2 + kstep;
            unsigned vo2[2][2];
#pragma unroll
            for (int _h = 0; _h < 2; ++_h)
#pragma unroll
                for (int _i = 0; _i < 2; ++_i) vo2[_h][_i] = (Sched::GATHER && last) ? nvoA[_h][_i] : voA[_h][_i];
            PG8_LDB(B0, 0, 0); PG8_LDB(B1, 0, 1); PG8_SCHED; PG8_LDA(At, 0, 0); PG8_STAGE(PG8_SA(1, 1), a1, voA[1]);
            PG8_WAIT_V(8); PG8_WAIT_L(0); PG8_BAR; PG8_MMA(0, 0, At, B0); PG8_MMA(0, 1, At, B1); PG8_BAR; PG8_SCHED;
            PG8_LDA(At, 0, 1); PG8_STAGE(PG8_SB(0, 0), b2, voffB); PG8_STAGE(PG8_SB(0, 1), b2 + hstepB, voffB); PG8_STAGE(PG8_SA(0, 0), a2, vo2[0]);
            PG8_WAIT_V(8); PG8_WAIT_L(0); PG8_BAR; PG8_MMA(1, 0, At, B0); PG8_MMA(1, 1, At, B1); PG8_BAR; PG8_SCHED;
            PG8_LDB(B0, 1, 0); PG8_LDB(B1, 1, 1); PG8_SCHED; PG8_LDA(At, 1, 0); PG8_STAGE(PG8_SA(0, 1), a2, vo2[1]);
            PG8_WAIT_V(8); PG8_WAIT_L(0); PG8_BAR; PG8_MMA(0, 0, At, B0); PG8_MMA(0, 1, At, B1); PG8_BAR; PG8_SCHED;
            PG8_LDA(At, 1, 1); PG8_STAGE(PG8_SB(1, 0), b3, voffB); PG8_STAGE(PG8_SB(1, 1), b3 + hstepB, voffB); PG8_STAGE(PG8_SA(1, 0), a3, vo2[0]);
            PG8_WAIT_V(8); PG8_WAIT_L(0); PG8_BAR; PG8_MMA(1, 0, At, B0); PG8_MMA(1, 1, At, B1); PG8_BAR; PG8_SCHED;
        }
        if (wr == 0) PG8_BAR;
        E(acc, cur, wr, wc, fr, fq);
        if (!has_next) break;
#pragma unroll
        for (int a = 0; a < 2; ++a)
#pragma unroll
            for (int b = 0; b < 2; ++b)
#pragma unroll
                for (int m = 0; m < 4; ++m)
#pragma unroll
                    for (int n = 0; n < 2; ++n) acc[a][b][m][n] = (f32x4){0.f, 0.f, 0.f, 0.f};
        cur = nxt; cA = nA; cB = nB; ++ui;
        if constexpr (Sched::GATHER) {
#pragma unroll
            for (int _h = 0; _h < 2; ++_h)
#pragma unroll
                for (int _i = 0; _i < 2; ++_i) voA[_h][_i] = nvoA[_h][_i]; }
        if (wr == 1) PG8_BAR;
    }
    PG8_WAIT_V(0);
    PG8_BAR;
#undef PG8_SA
#undef PG8_SB
#undef PG8_STAGE
#undef PG8_GATHER
#undef PG8_LDA
#undef PG8_LDB
#undef PG8_MMA
#undef PG8_WAIT_V
#undef PG8_WAIT_L
#undef PG8_BAR
#undef PG8_SCHED
}
}

namespace att {
constexpr int NW = 8, QBLK = 32, KVBLK = 64;
constexpr float THR = 8.f;
#define SBAR() __builtin_amdgcn_sched_barrier(0)
__device__ __forceinline__ int crow(int r, int hi) { return (r & 3) + 8 * (r >> 2) + 4 * hi; }
__device__ __forceinline__ unsigned cvtpk(float lo, float hi) { unsigned r; asm volatile("v_cvt_pk_bf16_f32 %0, %1, %2" : "=v"(r) : "v"(lo), "v"(hi)); return r; }
#ifndef PP_PRIO
#define PP_PRIO 1
#endif
#ifndef PP_VIS
#define PP_VIS 1
#endif
#ifndef VLD_IN_M
#define VLD_IN_M 1
#endif
#ifndef KLD_IN_M
#define KLD_IN_M 1
#endif
#ifndef MSTG_STEP
#define MSTG_STEP 1
#endif
#ifndef PP_ILV
#define PP_ILV 1
#endif
#ifndef PP_GHW
#define PP_GHW 1
#endif
#ifndef KROW192
#define KROW192 400
#endif
#ifndef KSWZ_MASK
#define KSWZ_MASK 15
#endif
template <int DK> __device__ __forceinline__ int kswz(int byte_off, int row) { if constexpr (DK == 128) return byte_off ^ ((row & KSWZ_MASK) << 4); else return KROW192 == 384 ? (byte_off ^ ((row & 7) << 4)) : byte_off; }
template <int DK> struct Cfg {
    static constexpr float SCALE = DK == 128 ? 0.088388347648318440f : 0.072168783648703220f;
    static constexpr int KROW = DK == 128 ? 256 : KROW192, SHM_V = KVBLK * 128 * 2, SHM_K = KVBLK * KROW, OFF_K = 2 * SHM_V, OFF_WS = OFF_K + 2 * SHM_K, BYTES = OFF_WS + NW * 64 * 4;
};
static_assert(Cfg<192>::BYTES <= 86016 && Cfg<128>::BYTES <= 86016, "parked-Q slots start at 86016");
template <int DK>
__device__ __forceinline__ void partialSM(f32x16& p0, f32x16& p1, float& m_reg, float& mn, float& alpha) {
    constexpr float SC = Cfg<DK>::SCALE, C = SC * 1.4426950408889634f;
    float pmax = p0[0];
#pragma unroll
    for (int r = 1; r < 16; ++r) pmax = fmaxf(pmax, p0[r]);
#pragma unroll
    for (int r = 0; r < 16; ++r) pmax = fmaxf(pmax, p1[r]);
    { auto rr = __builtin_amdgcn_permlane32_swap(__float_as_uint(pmax), __float_as_uint(pmax), false, false);
      pmax = fmaxf(__uint_as_float(rr[0]), __uint_as_float(rr[1])); }
    if (__builtin_expect(__all(pmax - m_reg <= THR / SC), 1)) { mn = m_reg; alpha = 1.f; }
    else { mn = fmaxf(m_reg, pmax); alpha = __builtin_amdgcn_exp2f((m_reg - mn) * C); m_reg = mn; }
    const float mnC = -mn * C;
#pragma unroll
    for (int r = 0; r < 16; ++r) p0[r] = fmaf(p0[r], C, mnC);
#pragma unroll
    for (int r = 0; r < 16; ++r) p1[r] = fmaf(p1[r], C, mnC);
#pragma unroll
    for (int r = 0; r < 16; ++r) p0[r] = __builtin_amdgcn_exp2f(p0[r]);
}
constexpr float THR2 = THR * 1.4426950408889634f;
__device__ __forceinline__ void partialSM3(f32x16& p0, f32x16& p1, float& m_run, float& alpha, unsigned& mpk, bool force) {
    float pmax = p0[0];
#pragma unroll
    for (int r = 1; r < 16; ++r) pmax = fmaxf(pmax, p0[r]);
#pragma unroll
    for (int r = 0; r < 16; ++r) pmax = fmaxf(pmax, p1[r]);
    { auto rr = __builtin_amdgcn_permlane32_swap(__float_as_uint(pmax), __float_as_uint(pmax), false, false);
      pmax = fmaxf(__uint_as_float(rr[0]), __uint_as_float(rr[1])); }
    if (__builtin_expect(!force && __all(pmax <= THR2), 1)) { alpha = 1.f; }
    else { const float d = force ? pmax : fmaxf(pmax, 0.f), mn = m_run + d;
        const unsigned hb = cvtpk(mn, 0.f) & 0xffffu; const float hf = __uint_as_float(hb << 16);
        const unsigned lb = cvtpk(mn - hf, 0.f) & 0xffffu; const float lf = __uint_as_float(lb << 16);
        const float mq = hf + lf, de = mq - m_run;
        alpha = force ? 1.f : __builtin_amdgcn_exp2f(-de); m_run = mq; mpk = (hb ^ 0x8000u) | ((lb ^ 0x8000u) << 16);
#pragma unroll
        for (int r = 0; r < 16; ++r) { p0[r] -= de; p1[r] -= de; } }
#pragma unroll
    for (int r = 0; r < 16; ++r) p0[r] = __builtin_amdgcn_exp2f(p0[r]);
}
__device__ __forceinline__ void finishSM(f32x16& p0, f32x16& p1, float alpha, float& l_reg, bf16x8& pa0, bf16x8& pa1, bf16x8& pa2, bf16x8& pa3) {
#pragma unroll
    for (int r = 0; r < 16; ++r) p1[r] = __builtin_amdgcn_exp2f(p1[r]);
    float ps = 0;
#pragma unroll
    for (int r = 0; r < 16; ++r) ps += p0[r];
#pragma unroll
    for (int r = 0; r < 16; ++r) ps += p1[r];
    { auto rr = __builtin_amdgcn_permlane32_swap(__float_as_uint(ps), __float_as_uint(ps), false, false);
      ps = __uint_as_float(rr[0]) + __uint_as_float(rr[1]); }
    l_reg = l_reg * alpha + ps;
#define PK4(P, BASE, OUT) do { unsigned a0 = cvtpk(P[BASE + 0], P[BASE + 1]), a1 = cvtpk(P[BASE + 2], P[BASE + 3]);   \
    unsigned b0 = cvtpk(P[BASE + 4], P[BASE + 5]), b1 = cvtpk(P[BASE + 6], P[BASE + 7]);                              \
    auto r0 = __builtin_amdgcn_permlane32_swap(a0, b0, false, false); auto r1 = __builtin_amdgcn_permlane32_swap(a1, b1, false, false); \
    u32x4 w = {r0[0], r1[0], r0[1], r1[1]}; OUT = *reinterpret_cast<bf16x8*>(&w); } while (0)
    PK4(p0, 0, pa0); PK4(p0, 8, pa1); PK4(p1, 0, pa2); PK4(p1, 8, pa3);
#undef PK4
}
template <int DK, int NQR>
__device__ __forceinline__ void qkt(f32x16& p0, f32x16& p1, const LAS char* Ks, const bf16x8* qr, const LAS char* qx, int r32, int hi) {
    constexpr int KROW = Cfg<DK>::KROW;
    p0 = f32x16{}; p1 = f32x16{};
#pragma unroll
    for (int d0 = 0; d0 < DK / 16; ++d0) { const int cb = (d0 * 16 + hi * 8) * 2, sw = kswz<DK>(cb, r32);
        const bf16x8 b0 = *reinterpret_cast<const LAS bf16x8*>(Ks + r32 * KROW + sw);
        const bf16x8 b1 = *reinterpret_cast<const LAS bf16x8*>(Ks + (32 + r32) * KROW + sw);
        bf16x8 q;
        if constexpr (true) { if (d0 < NQR) q = qr[d0]; else q = *reinterpret_cast<const LAS bf16x8*>(qx + ((2 * (d0 - NQR) + hi) << 4)); }
        p0 = __builtin_amdgcn_mfma_f32_32x32x16_bf16(b0, q, p0, 0, 0, 0);
        p1 = __builtin_amdgcn_mfma_f32_32x32x16_bf16(b1, q, p1, 0, 0, 0); }
}
#ifndef QLA
#define QLA 2
#endif
template <int DK, int NQR, int LA>
__device__ __forceinline__ void qkt_pipe(f32x16& p0, f32x16& p1, const LAS char* Ks, const bf16x8* qr, const LAS char* qx, int r32, int hi) {
    constexpr int KROW = Cfg<DK>::KROW, ND = DK / 16;
    bf16x8 b0[ND], b1[ND], qp[ND - NQR + 1];
    p0 = f32x16{}; p1 = f32x16{};
#define QLD(d) do { const int cb_ = ((d) * 16 + hi * 8) * 2, sw_ = kswz<DK>(cb_, r32);                                          \
    b0[d] = *reinterpret_cast<const LAS bf16x8*>(Ks + r32 * KROW + sw_); b1[d] = *reinterpret_cast<const LAS bf16x8*>(Ks + (32 + r32) * KROW + sw_);        \
    if ((d) >= NQR) qp[(d) >= NQR ? (d) - NQR : 0] = *reinterpret_cast<const LAS bf16x8*>(qx + ((2 * ((d) - NQR) + hi) << 4)); } while (0)
#pragma unroll
    for (int d0 = 0; d0 < LA; ++d0) QLD(d0);
    SBAR();
#pragma unroll
    for (int d0 = 0; d0 < ND; ++d0) {
        if (d0 + LA < ND) QLD(d0 + LA < ND ? d0 + LA : 0);
        bf16x8 q;
        if (d0 < NQR) q = qr[d0 < NQR ? d0 : 0]; else q = qp[d0 >= NQR ? d0 - NQR : 0];
        SBAR();
        p0 = __builtin_amdgcn_mfma_f32_32x32x16_bf16(b0[d0], q, p0, 0, 0, 0);
        p1 = __builtin_amdgcn_mfma_f32_32x32x16_bf16(b1[d0], q, p1, 0, 0, 0);
        SBAR();
    }
#undef QLD
}
__device__ __forceinline__ int v_st(int k, int c) { const int kk = (k & ~0xC) | ((k & 4) << 1) | ((k & 8) >> 1); return ((kk >> 3) * 4 + (c >> 5)) * 512 + ((kk & 7) * 32 + (c & 31)) * 2; }
__device__ __forceinline__ int v_rd_base(int lane) { return ((lane & 3) << 3) | (((lane >> 2) & 3) << 6) | (((lane >> 4) & 1) << 5) | (((lane >> 5) & 1) << 8); }
constexpr int v_rd_off(int d0, int ks, int half) { return d0 * 512 + ks * 4096 + half * 2048; }
template <int OFF> __device__ __forceinline__ s16x4 tr_read(int vb) {
    s16x4 r; asm volatile("ds_read_b64_tr_b16 %0, %1 offset:%2" : "=&v"(r) : "v"(vb), "i"(OFF) : "memory"); return r;
}
template <int D0> __device__ __forceinline__ void pv_one(f32x16& od, int vb, bf16x8 pa0, bf16x8 pa1, bf16x8 pa2, bf16x8 pa3) {
    const s16x4 l0 = tr_read<v_rd_off(D0, 0, 0)>(vb), h0 = tr_read<v_rd_off(D0, 0, 1)>(vb), l1 = tr_read<v_rd_off(D0, 1, 0)>(vb), h1 = tr_read<v_rd_off(D0, 1, 1)>(vb);
    const s16x4 l2 = tr_read<v_rd_off(D0, 2, 0)>(vb), h2 = tr_read<v_rd_off(D0, 2, 1)>(vb), l3 = tr_read<v_rd_off(D0, 3, 0)>(vb), h3 = tr_read<v_rd_off(D0, 3, 1)>(vb);
    asm volatile("s_waitcnt lgkmcnt(0)" ::: "memory"); SBAR();
#define PK(L, H) (bf16x8){L[0], L[1], L[2], L[3], H[0], H[1], H[2], H[3]}
    od = __builtin_amdgcn_mfma_f32_32x32x16_bf16(pa0, PK(l0, h0), od, 0, 0, 0);
    od = __builtin_amdgcn_mfma_f32_32x32x16_bf16(pa1, PK(l1, h1), od, 0, 0, 0);
    od = __builtin_amdgcn_mfma_f32_32x32x16_bf16(pa2, PK(l2, h2), od, 0, 0, 0);
    od = __builtin_amdgcn_mfma_f32_32x32x16_bf16(pa3, PK(l3, h3), od, 0, 0, 0);
#undef PK
}
__device__ __forceinline__ void pv_d0(f32x16* o, int vb, bf16x8 pa0, bf16x8 pa1, bf16x8 pa2, bf16x8 pa3) {
    pv_one<0>(o[0], vb, pa0, pa1, pa2, pa3); pv_one<1>(o[1], vb, pa0, pa1, pa2, pa3); pv_one<2>(o[2], vb, pa0, pa1, pa2, pa3); pv_one<3>(o[3], vb, pa0, pa1, pa2, pa3);
}
struct VFr { s16x4 f[8]; };
template <int D0> __device__ __forceinline__ void v_req(VFr& g, int vb) {
    g.f[0] = tr_read<v_rd_off(D0, 0, 0)>(vb); g.f[1] = tr_read<v_rd_off(D0, 0, 1)>(vb); g.f[2] = tr_read<v_rd_off(D0, 1, 0)>(vb); g.f[3] = tr_read<v_rd_off(D0, 1, 1)>(vb);
    g.f[4] = tr_read<v_rd_off(D0, 2, 0)>(vb); g.f[5] = tr_read<v_rd_off(D0, 2, 1)>(vb); g.f[6] = tr_read<v_rd_off(D0, 3, 0)>(vb); g.f[7] = tr_read<v_rd_off(D0, 3, 1)>(vb);
}
__device__ __forceinline__ void pv_mm(f32x16& od, const VFr& g, bf16x8 pa0, bf16x8 pa1, bf16x8 pa2, bf16x8 pa3) {
#define PK(L, H) (bf16x8){L[0], L[1], L[2], L[3], H[0], H[1], H[2], H[3]}
    od = __builtin_amdgcn_mfma_f32_32x32x16_bf16(pa0, PK(g.f[0], g.f[1]), od, 0, 0, 0);
    od = __builtin_amdgcn_mfma_f32_32x32x16_bf16(pa1, PK(g.f[2], g.f[3]), od, 0, 0, 0);
    od = __builtin_amdgcn_mfma_f32_32x32x16_bf16(pa2, PK(g.f[4], g.f[5]), od, 0, 0, 0);
    od = __builtin_amdgcn_mfma_f32_32x32x16_bf16(pa3, PK(g.f[6], g.f[7]), od, 0, 0, 0);
#undef PK
}
__device__ __forceinline__ void pv_rest(f32x16* o, VFr& ga, VFr& gb, int vb, bf16x8 pa0, bf16x8 pa1, bf16x8 pa2, bf16x8 pa3) {
    SBAR(); asm volatile("s_waitcnt lgkmcnt(0)" ::: "memory"); SBAR();
    pv_mm(o[0], ga, pa0, pa1, pa2, pa3); SBAR(); v_req<2>(ga, vb); SBAR();
    pv_mm(o[1], gb, pa0, pa1, pa2, pa3); SBAR(); v_req<3>(gb, vb); asm volatile("s_waitcnt lgkmcnt(8)" ::: "memory"); SBAR();
    pv_mm(o[2], ga, pa0, pa1, pa2, pa3); SBAR(); asm volatile("s_waitcnt lgkmcnt(0)" ::: "memory"); SBAR();
    pv_mm(o[3], gb, pa0, pa1, pa2, pa3);
}
template <int OFF> __device__ __forceinline__ s16x4 tr_readv(int vb) { return __builtin_amdgcn_ds_read_tr16_b64_v4i16((LAS s16x4*)(unsigned)(vb + OFF)); }
template <int D0> __device__ __forceinline__ void v_reqv(VFr& g, int vb) {
    g.f[0] = tr_readv<v_rd_off(D0, 0, 0)>(vb); g.f[1] = tr_readv<v_rd_off(D0, 0, 1)>(vb); g.f[2] = tr_readv<v_rd_off(D0, 1, 0)>(vb); g.f[3] = tr_readv<v_rd_off(D0, 1, 1)>(vb);
    g.f[4] = tr_readv<v_rd_off(D0, 2, 0)>(vb); g.f[5] = tr_readv<v_rd_off(D0, 2, 1)>(vb); g.f[6] = tr_readv<v_rd_off(D0, 3, 0)>(vb); g.f[7] = tr_readv<v_rd_off(D0, 3, 1)>(vb);
}
__device__ __forceinline__ void pv_rest2(f32x16* o, VFr& ga, VFr& gb, int vb, bf16x8 pa0, bf16x8 pa1, bf16x8 pa2, bf16x8 pa3) {
    SBAR(); pv_mm(o[0], ga, pa0, pa1, pa2, pa3); SBAR(); v_reqv<2>(ga, vb); SBAR();
    pv_mm(o[1], gb, pa0, pa1, pa2, pa3); SBAR(); v_reqv<3>(gb, vb); SBAR();
    pv_mm(o[2], ga, pa0, pa1, pa2, pa3); SBAR();
    pv_mm(o[3], gb, pa0, pa1, pa2, pa3);
}
template <int DK, int NQR, int LA>
__device__ __forceinline__ void qkt_pipe2(f32x16& p0, f32x16& p1, const LAS char* Ks, const bf16x8* qr, const LAS char* qx, int r32, int hi, VFr& ga, VFr& gb, int vb) {
    constexpr int KROW = Cfg<DK>::KROW, ND = DK / 16;
    bf16x8 b0[ND], b1[ND], qp[ND - NQR + 1];
    p0 = f32x16{}; p1 = f32x16{};
#define QLD(d) do { const int cb_ = ((d) * 16 + hi * 8) * 2, sw_ = kswz<DK>(cb_, r32);                                          \
    b0[d] = *reinterpret_cast<const LAS bf16x8*>(Ks + r32 * KROW + sw_); b1[d] = *reinterpret_cast<const LAS bf16x8*>(Ks + (32 + r32) * KROW + sw_);        \
    if ((d) >= NQR) qp[(d) >= NQR ? (d) - NQR : 0] = *reinterpret_cast<const LAS bf16x8*>(qx + ((2 * ((d) - NQR) + hi) << 4)); } while (0)
#pragma unroll
    for (int d0 = 0; d0 < LA; ++d0) QLD(d0);
    SBAR(); v_reqv<0>(ga, vb); SBAR();
#pragma unroll
    for (int d0 = 0; d0 < ND; ++d0) {
        if (d0 + LA < ND) QLD(d0 + LA < ND ? d0 + LA : 0);
        if (d0 == ND / 2 - 1) { SBAR(); v_reqv<1>(gb, vb); }
        bf16x8 q;
        if (d0 < NQR) q = qr[d0 < NQR ? d0 : 0]; else q = qp[d0 >= NQR ? d0 - NQR : 0];
        SBAR();
        p0 = __builtin_amdgcn_mfma_f32_32x32x16_bf16(b0[d0], q, p0, 0, 0, 0);
        p1 = __builtin_amdgcn_mfma_f32_32x32x16_bf16(b1[d0], q, p1, 0, 0, 0);
        SBAR();
    }
#undef QLD
}
__device__ __forceinline__ s16x4 tr_rd(int vb, int off) { return __builtin_amdgcn_ds_read_tr16_b64_v4i16((LAS s16x4*)(unsigned)(vb + off)); }
template <int ND> __device__ __forceinline__ constexpr int pair_of(int s) { return ND == 8 ? s : ((s % 3 != 2) ? (s / 3) * 2 + (s % 3) : -1); }
template <int DK, int NQR, int LA, class Mid>
__device__ __forceinline__ void m_seg(f32x16& p0, f32x16& p1, f32x16* o, const LAS char* Ks, const bf16x8* qr, const LAS char* qx, int r32, int hi, int vb, bf16x8 pa0, bf16x8 pa1, bf16x8 pa2, bf16x8 pa3, unsigned mpk, const Mid& mid) {
    constexpr int KROW = Cfg<DK>::KROW, ND = DK / 16;
    bf16x8 b0[ND], b1[ND], qp[ND - NQR + 1]; s16x4 vf[8][4];
    p0 = f32x16{}; p1 = f32x16{};
#define QLD(d) do { const int cb_ = ((d) * 16 + hi * 8) * 2, sw_ = kswz<DK>(cb_, r32);                                          \
    b0[d] = *reinterpret_cast<const LAS bf16x8*>(Ks + r32 * KROW + sw_); b1[d] = *reinterpret_cast<const LAS bf16x8*>(Ks + (32 + r32) * KROW + sw_);        \
    if ((d) >= NQR) qp[(d) >= NQR ? (d) - NQR : 0] = *reinterpret_cast<const LAS bf16x8*>(qx + ((2 * ((d) - NQR) + hi) << 4)); } while (0)
#define VLD(pp) do { const int d0_ = (pp) >> 1, kh_ = (pp) & 1;                                                                 \
    vf[pp][0] = tr_rd(vb, v_rd_off(d0_, 2 * kh_, 0)); vf[pp][1] = tr_rd(vb, v_rd_off(d0_, 2 * kh_, 1));                          \
    vf[pp][2] = tr_rd(vb, v_rd_off(d0_, 2 * kh_ + 1, 0)); vf[pp][3] = tr_rd(vb, v_rd_off(d0_, 2 * kh_ + 1, 1)); } while (0)
#define PK(L, H) (bf16x8){L[0], L[1], L[2], L[3], H[0], H[1], H[2], H[3]}
#pragma unroll
    for (int s = 0; s < LA; ++s) { QLD(s); if (pair_of<ND>(s) >= 0) VLD(pair_of<ND>(s) >= 0 ? pair_of<ND>(s) : 0); }
    SBAR();
    if (ACCI) {
        u32x4 one_ = {hi == 0 ? 0x3F803F80u : 0u, 0u, 0u, 0u}, qm_ = {hi == 0 ? mpk : 0u, 0u, 0u, 0u};
        p0 = __builtin_amdgcn_mfma_f32_32x32x16_bf16(*reinterpret_cast<bf16x8*>(&one_), *reinterpret_cast<bf16x8*>(&qm_), p0, 0, 0, 0);
        p1 = __builtin_amdgcn_mfma_f32_32x32x16_bf16(*reinterpret_cast<bf16x8*>(&one_), *reinterpret_cast<bf16x8*>(&qm_), p1, 0, 0, 0);
        SBAR(); }
#pragma unroll
    for (int s = 0; s < ND; ++s) {
        if (s + LA < ND) { QLD(s + LA < ND ? s + LA : 0); if (pair_of<ND>(s + LA) >= 0) VLD(pair_of<ND>(s + LA) >= 0 ? pair_of<ND>(s + LA) : 0); }
        bf16x8 q;
        if (s < NQR) q = qr[s < NQR ? s : 0]; else q = qp[s >= NQR ? s - NQR : 0];
        SBAR();
        p0 = __builtin_amdgcn_mfma_f32_32x32x16_bf16(b0[s], q, p0, 0, 0, 0);
        p1 = __builtin_amdgcn_mfma_f32_32x32x16_bf16(b1[s], q, p1, 0, 0, 0);
        if (pair_of<ND>(s) >= 0) { const int pp = pair_of<ND>(s) >= 0 ? pair_of<ND>(s) : 0; f32x16& od = o[pp >> 1];
            od = __builtin_amdgcn_mfma_f32_32x32x16_bf16((pp & 1) ? pa2 : pa0, PK(vf[pp][0], vf[pp][1]), od, 0, 0, 0);
            od = __builtin_amdgcn_mfma_f32_32x32x16_bf16((pp & 1) ? pa3 : pa1, PK(vf[pp][2], vf[pp][3]), od, 0, 0, 0); }
        SBAR();
        if (s == MSTG_STEP) { mid(); SBAR(); }
    }
#undef QLD
#undef VLD
#undef PK
}
__device__ __forceinline__ void store_o(const f32x16* o, const float* rli, LAS char* lds, gbf* Ob, int t, int hi) {
    const int w = t >> 6, lane = t & 63, r32 = lane & 31;
    LAS char* sl = lds + w * 8192;
#pragma unroll
    for (int r = 0; r < 16; r += 2) { const int row0 = crow(r, hi), row1 = crow(r + 1, hi);
#pragma unroll
        for (int d0 = 0; d0 < 4; ++d0) { const unsigned pk = cvtpk(o[d0][r] * rli[r], o[d0][r + 1] * rli[r + 1]);
            *(LAS unsigned short*)(sl + row0 * 256 + (d0 * 32 + r32) * 2) = (unsigned short)pk;
            *(LAS unsigned short*)(sl + row1 * 256 + (d0 * 32 + r32) * 2) = (unsigned short)(pk >> 16); } }
#pragma unroll
    for (int it = 0; it < 8; ++it) { const int q = it * 64 + lane, row = q >> 4, cc = q & 15;
        const bf16x8 v = *(const LAS bf16x8*)(sl + q * 16);
        *(GAS bf16x8*)(Ob + (size_t)(w * QBLK + row) * D + cc * 8) = v; }
}
struct DensePol {
    __device__ __forceinline__ bool active(int, int) const { return true; }
    __device__ __forceinline__ int tile_row(int j) const { return j * KVBLK; }
    __device__ __forceinline__ void hook(f32x16&, f32x16&, int, int, int, int) const {}
};
struct NaPol {
    int r_unit, rlo; const LAS float* rpb;
    __device__ __forceinline__ int tile_row(int j) const { return j < 4 ? j * KVBLK : CTX + (rlo + j - 4) * 64; }
    __device__ __forceinline__ bool active(int j, int wid) const {
        if (j < 4) return true; const int kr = rlo + j - 4, qrow = r_unit + (wid >> 1); int r0 = qrow - 4; r0 = r0 < 0 ? 0 : (r0 > 120 ? 120 : r0); return kr >= r0 && kr <= r0 + 7; }
    __device__ __forceinline__ void hook(f32x16& p0, f32x16& p1, int j, int wid, int r32, int hi) const {
        const bool loc = j >= 4;
        const int kr = rlo + j - 4, qrow = r_unit + (wid >> 1), qc = (wid & 1) * 32 + r32;
        int r0 = qrow - 4; r0 = r0 < 0 ? 0 : (r0 > 120 ? 120 : r0);
        int c0 = qc - 8; c0 = c0 < 0 ? 0 : (c0 > 48 ? 48 : c0);
        const bool row_ok = (kr >= r0) && (kr <= r0 + 7);
        const float fb = (loc && row_ok) ? 1.f : 0.f, fp = loc ? -1e29f : 0.f, rowpen = (loc && !row_ok) ? -1e30f : 0.f;
        const int rbase = (kr - qrow + 7) * 31 + 15 - qc;
#pragma unroll
        for (int r = 0; r < 16; ++r) { const int kc = crow(r, hi); const int d = kc - c0; int idx = rbase + kc; idx = idx < 0 ? 0 : (idx > 464 ? 464 : idx);
            p0[r] = (p0[r] + rowpen) + (fb * rpb[idx] + fp * fabsf((float)(d & ~15))); }
#pragma unroll
        for (int r = 0; r < 16; ++r) { const int kc = 32 + crow(r, hi); const int d = kc - c0; int idx = rbase + kc; idx = idx < 0 ? 0 : (idx > 464 ? 464 : idx);
            p1[r] = (p1[r] + rowpen) + (fb * rpb[idx] + fp * fabsf((float)(d & ~15))); }
    }
};
template <int DK, int LDQ, int LDK, int LDV, bool PIPE, int SDEPTH, int QLDS, class Pol>
__device__ __forceinline__ void attn_body(const gbf* Qb, const gbf* Kb, const gbf* Vb, gbf* Ob, int NT, LAS char* lds, const Pol& pol) {
    using C = Cfg<DK>; constexpr int ND = DK / 16, SHM_V = C::SHM_V, SHM_K = C::SHM_K, ldo = D;
    int tid_ = threadIdx.x; asm volatile("" : "+v"(tid_));
    const int tid = tid_, wid = __builtin_amdgcn_readfirstlane(tid >> 6), lane = tid & 63, r32 = lane & 31, hi = lane >> 5;
    LAS char* V_lds = lds; LAS char* K_lds = lds + C::OFF_K;
    LAS float* ws = (LAS float*)(lds + C::OFF_WS) + wid * 64; LAS float* li_l = ws; LAS float* al_l = ws + 32;
    constexpr int NQR = QLDS ? QLDS : ND;
    float m_reg = -1e30f, l_reg = 0; f32x16 o[4] = {}; bf16x8 qr[NQR];
    const gbf* Qw = Qb + (size_t)(wid * QBLK + r32) * LDQ + hi * 8;
    LAS char* qx = lds + 86016 + wid * (32 * 16 * 2 * (ND - NQR)) + r32 * (16 * 2 * (ND - NQR));
#pragma unroll
    for (int d0 = 0; d0 < ND; ++d0) { const bf16x8 q = *reinterpret_cast<const GAS bf16x8*>(Qw + d0 * 16);
        if (d0 < NQR) qr[d0 < NQR ? d0 : 0] = q; else *reinterpret_cast<LAS bf16x8*>(qx + ((2 * (d0 - NQR) + hi) << 4)) = q; }
    const int sr = tid >> 4, sc = (tid & 15) * 8, vst0 = v_st(sr, sc), vst1 = v_st(32 + sr, sc);
    const int kr_ = DK == 128 ? sr : (tid >> 3), kc_ = DK == 128 ? sc : (tid & 7) * 8;
    const int kst0 = DK == 128 ? sr * 256 + kswz<DK>(sc * 2, sr) : kr_ * C::KROW + kswz<DK>(kc_ * 2, kr_);
    const int kst1 = DK == 128 ? (32 + sr) * 256 + kswz<DK>(sc * 2, sr) : kr_ * C::KROW + kswz<DK>(kc_ * 2 + 128, kr_);
    const int kst2 = kr_ * C::KROW + kswz<DK>(kc_ * 2 + 256, kr_);
    const unsigned voffV = (unsigned)(sr * LDV + sc) * 2u, voffK = (unsigned)(kr_ * LDK + kc_) * 2u;
    const int vb0 = (int)(unsigned)(uintptr_t)V_lds + v_rd_base(lane);
    struct { bf16x8 vs0, vs1, ks0, ks1, ks2; } sr_[SDEPTH];
#define SLOAD(i, tile) do { const int _r0 = __builtin_amdgcn_readfirstlane(pol.tile_row(tile));                                                  \
    const GAS char* _vt = (const GAS char*)Vb + (size_t)_r0 * (LDV * 2); const GAS char* _kt = (const GAS char*)Kb + (size_t)_r0 * (LDK * 2);    \
    sr_[i].vs0 = *reinterpret_cast<const GAS bf16x8*>(_vt + voffV); sr_[i].vs1 = *reinterpret_cast<const GAS bf16x8*>(_vt + (size_t)(32 * LDV * 2) + voffV); \
    if constexpr (DK == 128) { sr_[i].ks0 = *reinterpret_cast<const GAS bf16x8*>(_kt + voffK); sr_[i].ks1 = *reinterpret_cast<const GAS bf16x8*>(_kt + (size_t)(32 * LDK * 2) + voffK); } \
    else { sr_[i].ks0 = *reinterpret_cast<const GAS bf16x8*>(_kt + voffK); sr_[i].ks1 = *reinterpret_cast<const GAS bf16x8*>(_kt + 128 + voffK); sr_[i].ks2 = *reinterpret_cast<const GAS bf16x8*>(_kt + 256 + voffK); } } while (0)
#define SWRITE(b, i) do { *(LAS bf16x8*)(V_lds + (b) * SHM_V + vst0) = sr_[i].vs0; *(LAS bf16x8*)(V_lds + (b) * SHM_V + vst1) = sr_[i].vs1;     \
    *(LAS bf16x8*)(K_lds + (b) * SHM_K + kst0) = sr_[i].ks0; *(LAS bf16x8*)(K_lds + (b) * SHM_K + kst1) = sr_[i].ks1;                            \
    if constexpr (DK == 192) *(LAS bf16x8*)(K_lds + (b) * SHM_K + kst2) = sr_[i].ks2; } while (0)
#define SWAIT() do { if constexpr (SDEPTH == 1) asm volatile("s_waitcnt vmcnt(0)" ::: "memory"); else if constexpr (DK == 128) asm volatile("s_waitcnt vmcnt(4)" ::: "memory"); else asm volatile("s_waitcnt vmcnt(5)" ::: "memory"); } while (0)
#define RESC(a) do { if (__any((a) < 1.f)) { if (hi == 0) al_l[r32] = (a); asm volatile("s_waitcnt lgkmcnt(0)" ::: "memory"); \
    _Pragma("unroll") for (int d = 0; d < 4; ++d) _Pragma("unroll") for (int r = 0; r < 16; ++r) o[d][r] *= al_l[crow(r, hi)]; } } while (0)
    bf16x8 pa0, pa1, pa2, pa3;
    if constexpr (PIPE && SDEPTH == 1 && ATT_EARLY) {
        f32x16 pA0, pA1, pB0, pB1; float mnA, mnB, alA, alB;
        SLOAD(0, 0); asm volatile("s_waitcnt vmcnt(0)" ::: "memory"); SWRITE(0, 0); SLOAD(0, 1); __syncthreads();
        qkt<DK, NQR>(pA0, pA1, K_lds, qr, qx, r32, hi); pol.hook(pA0, pA1, 0, wid, r32, hi); partialSM<DK>(pA0, pA1, m_reg, mnA, alA);
        asm volatile("s_waitcnt vmcnt(0)" ::: "memory"); SWRITE(1, 0); SLOAD(0, 2 < NT ? 2 : NT - 1); __syncthreads();
        for (int j = 1; j + 1 < NT; j += 2) {
            SBAR(); qkt<DK, NQR>(pB0, pB1, K_lds + SHM_K, qr, qx, r32, hi); pol.hook(pB0, pB1, j, wid, r32, hi);
            finishSM(pA0, pA1, alA, l_reg, pa0, pa1, pa2, pa3); SBAR();
            pv_d0(o, vb0, pa0, pa1, pa2, pa3); partialSM<DK>(pB0, pB1, m_reg, mnB, alB);
            __syncthreads(); asm volatile("s_waitcnt vmcnt(0)" ::: "memory"); SWRITE(0, 0); SLOAD(0, j + 2);
            RESC(alB); __syncthreads();
            SBAR(); qkt<DK, NQR>(pA0, pA1, K_lds, qr, qx, r32, hi); pol.hook(pA0, pA1, j + 1, wid, r32, hi);
            finishSM(pB0, pB1, alB, l_reg, pa0, pa1, pa2, pa3); SBAR();
            pv_d0(o, vb0 + SHM_V, pa0, pa1, pa2, pa3); partialSM<DK>(pA0, pA1, m_reg, mnA, alA);
            __syncthreads(); asm volatile("s_waitcnt vmcnt(0)" ::: "memory"); SWRITE(1, 0); SLOAD(0, j + 3 < NT ? j + 3 : NT - 1);
            RESC(alA); __syncthreads();
        }
        SBAR(); qkt<DK, NQR>(pB0, pB1, K_lds + SHM_K, qr, qx, r32, hi); pol.hook(pB0, pB1, NT - 1, wid, r32, hi);
        finishSM(pA0, pA1, alA, l_reg, pa0, pa1, pa2, pa3); SBAR();
        pv_d0(o, vb0, pa0, pa1, pa2, pa3); partialSM<DK>(pB0, pB1, m_reg, mnB, alB);
        __syncthreads(); RESC(alB);
        finishSM(pB0, pB1, alB, l_reg, pa0, pa1, pa2, pa3); SBAR();
        pv_d0(o, vb0 + SHM_V, pa0, pa1, pa2, pa3);
    } else if constexpr (PIPE) {
        f32x16 pA0, pA1, pB0, pB1; float mnA, mnB, alA, alB;
        constexpr int SE = 0, SO = SDEPTH - 1;
        SLOAD(SE, 0); asm volatile("s_waitcnt vmcnt(0)" ::: "memory"); SWRITE(0, SE); __syncthreads();
        qkt<DK, NQR>(pA0, pA1, K_lds, qr, qx, r32, hi); pol.hook(pA0, pA1, 0, wid, r32, hi); partialSM<DK>(pA0, pA1, m_reg, mnA, alA);
        SLOAD(SO, 1); if constexpr (SDEPTH == 2) { if (2 < NT) SLOAD(SE, 2); }
        SWAIT(); SWRITE(1, SO); __syncthreads();
        for (int j = 1; j + 1 < NT; j += 2) {
            SBAR(); qkt<DK, NQR>(pB0, pB1, K_lds + SHM_K, qr, qx, r32, hi); pol.hook(pB0, pB1, j, wid, r32, hi);
            finishSM(pA0, pA1, alA, l_reg, pa0, pa1, pa2, pa3); SBAR();
            SLOAD(SO, j + SDEPTH); SBAR();
            pv_d0(o, vb0, pa0, pa1, pa2, pa3); partialSM<DK>(pB0, pB1, m_reg, mnB, alB);
            __syncthreads(); SWAIT(); SWRITE(0, SE);
            RESC(alB); __syncthreads();
            SBAR(); qkt<DK, NQR>(pA0, pA1, K_lds, qr, qx, r32, hi); pol.hook(pA0, pA1, j + 1, wid, r32, hi);
            finishSM(pB0, pB1, alB, l_reg, pa0, pa1, pa2, pa3); SBAR();
            if (SDEPTH == 1 || j + 3 < NT) SLOAD(SE, j + 1 + SDEPTH); SBAR();
            pv_d0(o, vb0 + SHM_V, pa0, pa1, pa2, pa3); partialSM<DK>(pA0, pA1, m_reg, mnA, alA);
            __syncthreads(); SWAIT(); SWRITE(1, SO);
            RESC(alA); __syncthreads();
        }
        SBAR(); qkt<DK, NQR>(pB0, pB1, K_lds + SHM_K, qr, qx, r32, hi); pol.hook(pB0, pB1, NT - 1, wid, r32, hi);
        finishSM(pA0, pA1, alA, l_reg, pa0, pa1, pa2, pa3); SBAR();
        pv_d0(o, vb0, pa0, pa1, pa2, pa3); partialSM<DK>(pB0, pB1, m_reg, mnB, alB);
        __syncthreads(); RESC(alB);
        finishSM(pB0, pB1, alB, l_reg, pa0, pa1, pa2, pa3); SBAR();
        pv_d0(o, vb0 + SHM_V, pa0, pa1, pa2, pa3);
    } else {
        f32x16 p0, p1; float mn, al;
        SLOAD(0, 0); asm volatile("s_waitcnt vmcnt(0)" ::: "memory"); SWRITE(0, 0); __syncthreads();
        for (int j = 0; j < NT; ++j) {
            const int bsel = j & 1;
            if (j + 1 < NT) SLOAD(0, j + 1);
            const bool act = pol.active(j, wid);
            SBAR(); if (act) { qkt<DK, NQR>(p0, p1, K_lds + bsel * SHM_K, qr, qx, r32, hi); pol.hook(p0, p1, j, wid, r32, hi); }
            else {
#pragma unroll
                for (int r = 0; r < 16; ++r) { p0[r] = -1e30f; p1[r] = -1e30f; } }
            partialSM<DK>(p0, p1, m_reg, mn, al); RESC(al);
            finishSM(p0, p1, al, l_reg, pa0, pa1, pa2, pa3); SBAR();
            if (act) pv_d0(o, vb0 + bsel * SHM_V, pa0, pa1, pa2, pa3);
            if (j + 1 < NT) { asm volatile("s_waitcnt vmcnt(0)" ::: "memory"); SWRITE(bsel ^ 1, 0); }
            __syncthreads();
        }
    }
    __syncthreads();
    if (hi == 0) li_l[r32] = l_reg; asm volatile("s_waitcnt lgkmcnt(0)" ::: "memory");
    float rli[16];
#pragma unroll
    for (int r = 0; r < 16; ++r) rli[r] = __builtin_amdgcn_rcpf(li_l[crow(r, hi)]);
    int tid_o = threadIdx.x; asm volatile("" : "+v"(tid_o));
    store_o(o, rli, lds, Ob, tid_o, hi);
#undef SLOAD
#undef SWRITE
#undef SWAIT
#undef RESC
}

template <int DK, int LDQ, int LDK, int LDV, int QLDS, int LA, class Pol>
__device__ __forceinline__ void attn_pp(const gbf* Qb, const gbf* Kb, const gbf* Vb, gbf* Ob, int NT, LAS char* lds, const Pol& pol) {
    using C = Cfg<DK>; constexpr int ND = DK / 16, SHM_V = C::SHM_V, SHM_K = C::SHM_K, ldo = D;
    int tid_ = threadIdx.x; asm volatile("" : "+v"(tid_));
    const int tid = tid_, wid = __builtin_amdgcn_readfirstlane(tid >> 6), lane = tid & 63, r32 = lane & 31, hi = lane >> 5;
    LAS char* V_lds = lds; LAS char* K_lds = lds + C::OFF_K;
    LAS float* ws = (LAS float*)(lds + C::OFF_WS) + wid * 64; LAS float* li_l = ws; LAS float* al_l = ws + 32;
    int g;
    { const unsigned simd = (unsigned)__builtin_amdgcn_s_getreg((1 << 11) | (4 << 6) | 4);
      volatile LAS unsigned* sid = (volatile LAS unsigned*)(lds + C::OFF_WS);
      if (lane == 0) sid[wid * 64 + 32] = simd;
      __syncthreads();
      int cnt = 0;
#pragma unroll
      for (int w = 0; w < NW; ++w) cnt += (w < wid && sid[w * 64 + 32] == simd) ? 1 : 0;
      g = __builtin_amdgcn_readfirstlane(PP_GHW ? (cnt & 1) : (wid >> 2));
      __syncthreads(); }
    constexpr int NQR = QLDS ? QLDS : ND;
    float m_reg = ACCI ? 0.f : -1e30f, l_reg = 0; unsigned mpk = 0u;     f32x16 o[4] = {}; bf16x8 qr[NQR];
    const gbf* Qw = Qb + (size_t)(wid * QBLK + r32) * LDQ + hi * 8;
    LAS char* qx = lds + 86016 + wid * (32 * 16 * 2 * (ND - NQR)) + r32 * (16 * 2 * (ND - NQR));
#pragma unroll
    for (int d0 = 0; d0 < ND; ++d0) { const bf16x8 q = *reinterpret_cast<const GAS bf16x8*>(Qw + d0 * 16);
        if (d0 < NQR) qr[d0 < NQR ? d0 : 0] = q; else *reinterpret_cast<LAS bf16x8*>(qx + ((2 * (d0 - NQR) + hi) << 4)) = q; }
    const int sr = tid >> 4, sc = (tid & 15) * 8, vst0 = v_st(sr, sc), vst1 = v_st(32 + sr, sc);
    const int kr_ = DK == 128 ? sr : (tid >> 3), kc_ = DK == 128 ? sc : (tid & 7) * 8;
    const int kst0 = DK == 128 ? sr * 256 + kswz<DK>(sc * 2, sr) : kr_ * C::KROW + kswz<DK>(kc_ * 2, kr_);
    const int kst1 = DK == 128 ? (32 + sr) * 256 + kswz<DK>(sc * 2, sr) : kr_ * C::KROW + kswz<DK>(kc_ * 2 + 128, kr_);
    const int kst2 = kr_ * C::KROW + kswz<DK>(kc_ * 2 + 256, kr_);
    const unsigned voffV = (unsigned)(sr * LDV + sc) * 2u, voffK = (unsigned)(kr_ * LDK + kc_) * 2u;
    const int vb0 = (int)(unsigned)(uintptr_t)V_lds + v_rd_base(lane);
    const int kE = ((g + 1) & 1) * SHM_K, kO = (g & 1) * SHM_K, vE = (g & 1) * SHM_V, vO = ((g + 1) & 1) * SHM_V;
    bf16x8 vs0, vs1, ks0, ks1, ks2;
#define PLOADK(tile) do { const int _t = (tile) < NT ? (tile) : NT - 1; const int _r0 = __builtin_amdgcn_readfirstlane(pol.tile_row(_t));                     \
    const GAS char* _kt = (const GAS char*)Kb + (size_t)_r0 * (LDK * 2);                                                                                     \
    if constexpr (DK == 128) { ks0 = *reinterpret_cast<const GAS bf16x8*>(_kt + voffK); ks1 = *reinterpret_cast<const GAS bf16x8*>(_kt + (size_t)(32 * LDK * 2) + voffK); } \
    else { ks0 = *reinterpret_cast<const GAS bf16x8*>(_kt + voffK); ks1 = *reinterpret_cast<const GAS bf16x8*>(_kt + 128 + voffK); ks2 = *reinterpret_cast<const GAS bf16x8*>(_kt + 256 + voffK); } } while (0)
#define PLOADV(tile) do { const int _t = (tile) < NT ? (tile) : NT - 1; const int _r0 = __builtin_amdgcn_readfirstlane(pol.tile_row(_t));                     \
    const GAS char* _vt = (const GAS char*)Vb + (size_t)_r0 * (LDV * 2);                                                                                     \
    vs0 = *reinterpret_cast<const GAS bf16x8*>(_vt + voffV); vs1 = *reinterpret_cast<const GAS bf16x8*>(_vt + (size_t)(32 * LDV * 2) + voffV); } while (0)
#define PWRITEK(ko) do { *(LAS bf16x8*)(K_lds + (ko) + kst0) = ks0; *(LAS bf16x8*)(K_lds + (ko) + kst1) = ks1; if constexpr (DK == 192) *(LAS bf16x8*)(K_lds + (ko) + kst2) = ks2; } while (0)
#define PWRITEV(vo) do { *(LAS bf16x8*)(V_lds + (vo) + vst0) = vs0; *(LAS bf16x8*)(V_lds + (vo) + vst1) = vs1; } while (0)
#define PBAR() do { SBAR(); asm volatile("s_waitcnt lgkmcnt(0)\n\ts_barrier" ::: "memory"); SBAR(); } while (0)
#define PRESC(a) do { if (__any((a) < 1.f)) { if (hi == 0) al_l[r32] = (a); asm volatile("s_waitcnt lgkmcnt(0)" ::: "memory"); \
    _Pragma("unroll") for (int d = 0; d < 4; ++d) _Pragma("unroll") for (int r = 0; r < 16; ++r) o[d][r] *= al_l[crow(r, hi)]; } } while (0)
#define PSEGV(j, ko, vo) do { float mn_, al_; if (PP_PRIO) __builtin_amdgcn_s_setprio(0);                                                                        \
    asm volatile("s_waitcnt vmcnt(0)" ::: "memory"); PWRITEK(ko); PWRITEV(vo); SBAR();                  \
    if (ACCI) partialSM3(p0, p1, m_reg, al_, mpk, (j) == 0); else partialSM<DK>(p0, p1, m_reg, mn_, al_); finishSM(p0, p1, al_, l_reg, pa0, pa1, pa2, pa3); PRESC(al_);            \
    if (!(KLD_IN_M && DK == 128)) PLOADK((j) + g + 2); if (!(VLD_IN_M && DK == 128)) PLOADV((j) + g + 1); PBAR(); } while (0)
#if PP_ILV
#define PSEGM(j, kb, vb) do { if (PP_PRIO) __builtin_amdgcn_s_setprio(1); SBAR();                                                                              \
    m_seg<DK, NQR, LA>(p0, p1, o, K_lds + (kb) * SHM_K, qr, qx, r32, hi, vb0 + (vb) * SHM_V, pa0, pa1, pa2, pa3, mpk, [&]() __attribute__((always_inline)) { if (KLD_IN_M && DK == 128) PLOADK((j) + g + 1); if (VLD_IN_M && DK == 128) PLOADV((j) + g); }); pol.hook(p0, p1, (j), wid, r32, hi); PBAR(); } while (0)
#elif PP_VIS
#define PSEGM(j, kb, vb) do { VFr ga_, gb_; if (PP_PRIO) __builtin_amdgcn_s_setprio(1); SBAR();                                                                \
    qkt_pipe2<DK, NQR, LA>(p0, p1, K_lds + (kb) * SHM_K, qr, qx, r32, hi, ga_, gb_, vb0 + (vb) * SHM_V); pol.hook(p0, p1, (j), wid, r32, hi);                \
    pv_rest2(o, ga_, gb_, vb0 + (vb) * SHM_V, pa0, pa1, pa2, pa3); PBAR(); } while (0)
#else
#define PSEGM(j, kb, vb) do { VFr ga_, gb_; if (PP_PRIO) __builtin_amdgcn_s_setprio(1); SBAR(); v_req<0>(ga_, vb0 + (vb) * SHM_V); v_req<1>(gb_, vb0 + (vb) * SHM_V); SBAR();                              \
    qkt_pipe<DK, NQR, LA>(p0, p1, K_lds + (kb) * SHM_K, qr, qx, r32, hi); pol.hook(p0, p1, (j), wid, r32, hi);                                                \
    pv_rest(o, ga_, gb_, vb0 + (vb) * SHM_V, pa0, pa1, pa2, pa3); PBAR(); } while (0)
#endif
    bf16x8 pa0, pa1, pa2, pa3; f32x16 p0, p1;
    PLOADK(0); asm volatile("s_waitcnt vmcnt(0)" ::: "memory"); PWRITEK(0); PLOADK(1); PLOADV(0);
    PBAR();
    if (g) { asm volatile("s_waitcnt vmcnt(0)" ::: "memory"); PWRITEK(SHM_K); PWRITEV(0); PLOADK(2); PLOADV(1); PBAR(); }
    qkt<DK, NQR>(p0, p1, K_lds, qr, qx, r32, hi); pol.hook(p0, p1, 0, wid, r32, hi); PBAR();
    for (int j = 0; j + 2 < NT; j += 2) {
        PSEGV(j, kE, vE); PSEGM(j + 1, 1, 0);
        PSEGV(j + 1, kO, vO); PSEGM(j + 2, 0, 1);
    }
    PSEGV(NT - 2, kE, vE); PSEGM(NT - 1, 1, 0);
    PSEGV(NT - 1, kO, vO);
    { VFr ga_, gb_; SBAR(); v_req<0>(ga_, vb0 + SHM_V); v_req<1>(gb_, vb0 + SHM_V); pv_rest(o, ga_, gb_, vb0 + SHM_V, pa0, pa1, pa2, pa3); }
    if (!g) PBAR();
    if (PP_PRIO) __builtin_amdgcn_s_setprio(0);
    __syncthreads();
    if (hi == 0) li_l[r32] = l_reg; asm volatile("s_waitcnt lgkmcnt(0)" ::: "memory");
    float rli[16];
#pragma unroll
    for (int r = 0; r < 16; ++r) rli[r] = __builtin_amdgcn_rcpf(li_l[crow(r, hi)]);
    int tid_o = threadIdx.x; asm volatile("" : "+v"(tid_o));
    store_o(o, rli, lds, Ob, tid_o, hi);
#undef PLOADK
#undef PLOADV
#undef PWRITEK
#undef PWRITEV
#undef PBAR
#undef PRESC
#undef PSEGV
#undef PSEGM
}
}

#define XB_TMO      128
#define XB_XCNT(j)  (256  + 64 * (j))
#define XB_XSUB(j)  (1280 + 64 * (j))
#define XB_XGEN(j)  (2304 + 64 * (j))
#define XB_TOP      3328
#define XB_TOPGEN   3392
#define XCD_BAR_WORDS 3456
#define XB_SPIN_CAP (1u << 22)
__device__ __forceinline__ unsigned xb_ld(unsigned* p)              { return __hip_atomic_load(p, __ATOMIC_RELAXED, __HIP_MEMORY_SCOPE_AGENT); }
__device__ __forceinline__ unsigned xb_add(unsigned* p, unsigned v) { return __hip_atomic_fetch_add(p, v, __ATOMIC_RELAXED, __HIP_MEMORY_SCOPE_AGENT); }
__device__ __forceinline__ unsigned xb_xcc_id() { return (unsigned)__builtin_amdgcn_s_getreg((3 << 11) | 20) & 0xFu; }
#define XB_SPIN(cond, bar) do { unsigned _sp = 0; while (cond) { __builtin_amdgcn_s_sleep(1); \
    if ((++_sp & 255u) == 0u) { if (xb_ld(&(bar)[XB_TMO])) break; if (_sp > XB_SPIN_CAP) { atomicAdd(&(bar)[XB_TMO], 1u); break; } } } } while (0)
struct XcdBarrier { unsigned* bar; unsigned x; volatile LAS unsigned* st; };
__device__ __forceinline__ XcdBarrier xcd_barrier_post(unsigned* bar, volatile LAS unsigned* st) {
    XcdBarrier b; b.bar = bar; b.x = xb_xcc_id(); b.st = st;
    if (threadIdx.x == 0) (void)xb_add(&bar[XB_XCNT(b.x)], 1u);
    return b;
}
__device__ __forceinline__ void xcd_barrier_complete(unsigned* bar, unsigned x, unsigned& nloc, unsigned& nx) {
    const unsigned G = gridDim.x * gridDim.y * gridDim.z;
    unsigned sum, cnt, mine, sp = 0u;
    for (;;) {
        sum = 0u; cnt = 0u; mine = 0u;
#pragma unroll
        for (unsigned j = 0; j < 16; ++j) { const unsigned c = xb_ld(&bar[XB_XCNT(j)]); sum += c; cnt += (c > 0u) ? 1u : 0u; mine = (j == x) ? c : mine; }
        if (sum == G) break;
        __builtin_amdgcn_s_sleep(1);
        if ((++sp & 255u) == 0u) { if (xb_ld(&bar[XB_TMO])) break; if (sp > XB_SPIN_CAP) { atomicAdd(&bar[XB_TMO], 1u); break; } }
    }
    nloc = mine > 0u ? mine : 1u; nx = cnt > 0u ? cnt : 1u;
}
__device__ __forceinline__ void xcd_barrier(const XcdBarrier& b) {
    asm volatile("s_waitcnt vmcnt(0)" ::: "memory");
    __syncthreads();
    if (threadIdx.x == 0) {
        unsigned* bar = b.bar;
        __builtin_amdgcn_s_waitcnt(0);
        unsigned nloc = b.st[0], nx = b.st[1];
        if (nloc == 0u) { xcd_barrier_complete(bar, b.x, nloc, nx); b.st[0] = nloc; b.st[1] = nx; }
        const unsigned old = xb_add(&bar[XB_XSUB(b.x)], 1u);
        const unsigned gen = old / nloc;
        if (old + 1u == (gen + 1u) * nloc) {
            __builtin_amdgcn_fence(__ATOMIC_RELEASE, "agent");
            asm volatile("s_waitcnt vmcnt(0)" ::: "memory");
            const unsigned og = xb_add(&bar[XB_TOP], 1u);
            const unsigned tg = og / nx;
            if (og + 1u == (tg + 1u) * nx) xb_add(&bar[XB_TOPGEN], 1u);
            else XB_SPIN(xb_ld(&bar[XB_TOPGEN]) == tg, bar);
            __builtin_amdgcn_fence(__ATOMIC_ACQUIRE, "agent");
            xb_add(&bar[XB_XGEN(b.x)], 1u);
            asm volatile("s_waitcnt vmcnt(0)" ::: "memory");
        } else {
            XB_SPIN(xb_ld(&bar[XB_XGEN(b.x)]) == gen, bar);
            __builtin_amdgcn_fence(__ATOMIC_ACQUIRE, "agent");
            asm volatile("s_waitcnt vmcnt(0)" ::: "memory");
        }
    }
    __syncthreads();
}

constexpr int NWAVES = 8, NPHASES = 21;
#ifndef CV_FILL
#define CV_FILL 1
#endif
#ifndef MLA_SDEPTH
#define MLA_SDEPTH 1
#endif
#ifndef GQA_SDEPTH
#define GQA_SDEPTH 1
#endif
#ifndef GQA_NQR
#define GQA_NQR 0
#endif
#ifndef GQA_PP
#define GQA_PP 1
#endif
#ifndef MLA_PP
#define MLA_PP 1
#endif
#ifndef MLA_QLA
#define MLA_QLA 2
#endif
#ifndef MLA_PIPE
#define MLA_PIPE true
#endif
#ifndef MLA_QLDS
#define MLA_QLDS true
#endif
struct Args { const float* in[28]; float* out; unsigned char* ws; int ph_lo, ph_hi; };
#define INP(k) ((const gf32*)args.in[k])
struct Frame {
    LAS unsigned char* lds; volatile LAS unsigned* MISC; gu32* ctl;
    int tid, lane, wave, b, G;
    GAS unsigned char* ws;
    gf32* out;
};
__device__ __forceinline__ const gf32* MODP(const Frame& F, int l, int v, int ch) { return (const gf32*)(F.ws + WS_MOD) + (size_t)((l * 2 + v) * 6 + ch) * D; }

constexpr int I_IN = 16 * 17, I_UQ = 4 * 6, I_UKV = 4 * 8, I_OUT = 16 * 8, I_QKV = 16 * 12, I_O = 16 * 8, I_EXP = 96;
constexpr int NL0D = I_IN + I_UQ + I_UKV + I_OUT, NL0 = NL0D + NEX * I_EXP;
constexpr int NL1D = I_QKV + I_O, NL1 = NL1D + NEX * I_EXP;
constexpr int CW_CVQ = 8192;
__host__ __device__ __forceinline__ int ys_pos(int n) { const int q = n & 255; return (n - q) + 128 * ((q >> 3) & 1) + 32 * (q >> 6) + 8 * ((q >> 4) & 3) + (q & 7); }
struct CvTile { const gf32* src; gbf* dst; const gf32* ks; int K, N, n0, mode, aux; };
__device__ __forceinline__ CvTile cv_decode(const Frame& F, const Args& args, int it) {
    const gf32* W; gbf* WT; const gf32* ks = nullptr; int K, N, kb, nb, mode = 0, aux = 0; int r = it, l = 0; bool dense = true;
    if (r >= NL0) { r -= NL0; l = 1; }
    if (l == 0) {
        if (r < I_IN) { W = INP(8); K = D; N = NIN; WT = (gbf*)(F.ws + WS_WIN); kb = r / 17; nb = r % 17; }
        else if (r < I_IN + I_UQ) { r -= I_IN; W = INP(11); K = 512; N = 1536; WT = (gbf*)(F.ws + WS_WUQ); ks = INP(10); kb = r / 6; nb = r % 6; }
        else if (r < I_IN + I_UQ + I_UKV) { r -= I_IN + I_UQ; W = INP(13); K = 512; N = 2048; WT = (gbf*)(F.ws + WS_WUKV); ks = INP(12); kb = r / 8; nb = r % 8; }
        else if (r < NL0D) { r -= I_IN + I_UQ + I_UKV; W = INP(14); K = D; N = D; WT = (gbf*)(F.ws + WS_WOUT); kb = r / 8; nb = r % 8; }
        else { r -= NL0D; dense = false; }
    } else {
        if (r < I_QKV) { W = INP(15); K = D; N = 3072; WT = (gbf*)(F.ws + WS_WQKV); kb = r / 12; nb = r % 12; }
        else if (r < NL1D) { r -= I_QKV; W = INP(18); K = D; N = D; WT = (gbf*)(F.ws + WS_WO); kb = r / 8; nb = r % 8; }
        else { r -= NL1D; dense = false; }
    }
    if (!dense) {
        const int e = r / I_EXP, sub = r % I_EXP, mat = sub / 32, q = sub % 32;
        if (mat < 2) {
            W = e == 0 ? INP(24 + mat) + (size_t)l * D * DE : INP(21 + mat) + ((size_t)l * NE + (e - 1)) * D * DE;
            K = D; N = DE; if (CV_KADJ) { nb = q / 16; kb = q % 16; } else { kb = q / 2; nb = q % 2; } mode = 1; aux = mat;
            WT = (gbf*)(F.ws + WS_GU + ((size_t)l * NEX + e) * GU_BYTES);
        } else {
            W = e == 0 ? INP(26) + (size_t)l * DE * D : INP(23) + ((size_t)l * NE + (e - 1)) * DE * D;
            K = DE; N = D; if (CV_KADJ) { nb = q / 4; kb = q % 4; } else { kb = q / 8; nb = q % 8; } mode = 2;
            WT = (gbf*)(F.ws + WS_DN + ((size_t)l * NEX + e) * DN_BYTES);
        }
    }
    CvTile c; c.n0 = 256 * nb; c.mode = mode; c.aux = aux; c.src = W + (size_t)(128 * kb) * N + 256 * nb; c.dst = WT + 128 * kb; c.ks = ks ? ks + 128 * kb : nullptr; c.K = K; c.N = N; return c;
}
__device__ __forceinline__ int cv_row(const CvTile& c, int n) { return c.mode == 0 ? n : (c.mode == 1 ? 256 * (n >> 7) + 128 * c.aux + (n & 127) : ys_pos(n)); }
__device__ __forceinline__ void cv_load(const CvTile& c, f32x4 (&v)[16], int tid) {
    const int w = tid >> 6, L = tid & 63; const int col = c.n0 + 4 * L < c.N ? 4 * L : 0;
    const gf32* p = c.src + (size_t)(16 * w) * c.N + col;
#pragma unroll
    for (int r = 0; r < 16; ++r) v[r] = *(const GAS f32x4*)(p + (size_t)r * c.N);
}
__device__ __forceinline__ void cv_to_lds(const CvTile& c, f32x4 (&v)[16], LAS unsigned* img, int tid) {
    const int w = tid >> 6, L = tid & 63;
#pragma unroll
    for (int p = 0; p < 8; ++p) { f32x4 a = v[2 * p], b = v[2 * p + 1];
        if (c.ks) { a *= c.ks[16 * w + 2 * p]; b *= c.ks[16 * w + 2 * p + 1]; }
        const int kp = 8 * w + p;
        *(LAS u32x4*)(img + kp * 256 + ((L ^ (kp >> 2)) & 63) * 4) = (u32x4){pk2(a[0], b[0]), pk2(a[1], b[1]), pk2(a[2], b[2]), pk2(a[3], b[3])}; }
}
__device__ __forceinline__ void cv_from_lds(const CvTile& c, const LAS unsigned* img, int tid) {
    const int ci = tid & 15, nl = tid >> 4;
#pragma unroll
    for (int q = 0; q < 8; ++q) { const int n = nl + 32 * q, nt = c.n0 + n;
        u32x4 o;
#pragma unroll
        for (int i = 0; i < 4; ++i) o[i] = img[(4 * ci + i) * 256 + (((n >> 2) ^ ci) & 63) * 4 + (n & 3)];
        if (nt < c.N) *(GAS u32x4*)(c.dst + (size_t)cv_row(c, nt) * c.K + 8 * ci) = o; }
}
__device__ __forceinline__ int cv_run_drain(const Frame& F, const Args& args, int it0, int step, int end) {
    LAS unsigned* img = (LAS unsigned*)(F.lds + RING_OFF);
    f32x4 va[16], vb[16]; CvTile ca, cb; int it = it0;
    const int last = it0 + ((end - 1 - it0) / step) * step;
#define CV_CLAMP(x) ((x) < end ? (x) : last)
    ca = cv_decode(F, args, it); cv_load(ca, va, F.tid);
    cb = cv_decode(F, args, CV_CLAMP(it + step)); cv_load(cb, vb, F.tid);
#define CV_STEP(CUR, VCUR) { const CvTile _old = CUR;                                                                                       \
        __syncthreads(); cv_to_lds(_old, VCUR, img, F.tid);                                                                                  \
        CUR = cv_decode(F, args, CV_CLAMP(it + 2 * step)); cv_load(CUR, VCUR, F.tid);                                                        \
        __syncthreads(); cv_from_lds(_old, img, F.tid);                                                                                      \
        it += step; if (it >= end) break; }
    for (;;) {
        CV_STEP(ca, va)
        CV_STEP(cb, vb)
    }
#undef CV_STEP
#undef CV_CLAMP
    asm volatile("s_waitcnt vmcnt(0)" ::: "memory");
    __syncthreads();
    return end;
}
__device__ __forceinline__ int cv_run_seq(const Frame& F, const Args& args, int it0, int step, int end, gu32* done_word = nullptr, unsigned done_target = 0u) {
    if (it0 >= end) return it0;
    if (CV_DEEP_DRAIN && done_word == nullptr) return cv_run_drain(F, args, it0, step, end);
    LAS unsigned* img = (LAS unsigned*)(F.lds + RING_OFF); volatile LAS unsigned* flag = F.MISC + 40;
    f32x4 va[16], vb[16]; CvTile ca, cb; int it = it0, ret = end;
    ca = cv_decode(F, args, it); cv_load(ca, va, F.tid);
    for (;;) {
        const int n1 = it + step; const bool h1 = n1 < end;
        cb = cv_decode(F, args, h1 ? n1 : it); cv_load(cb, vb, F.tid);
        if (done_word && F.tid == 0) flag[0] = __hip_atomic_load(done_word, RLX_AGENT) >= done_target ? 1u : 0u;
        __syncthreads(); cv_to_lds(ca, va, img, F.tid); __syncthreads(); cv_from_lds(ca, img, F.tid);
        if (!h1) break;
        if (done_word && flag[0]) { ret = n1; break; }
        const int n2 = n1 + step; const bool h2 = n2 < end;
        ca = cv_decode(F, args, h2 ? n2 : n1); cv_load(ca, va, F.tid);
        if (done_word && F.tid == 0) flag[1] = __hip_atomic_load(done_word, RLX_AGENT) >= done_target ? 1u : 0u;
        __syncthreads(); cv_to_lds(cb, vb, img, F.tid); __syncthreads(); cv_from_lds(cb, img, F.tid);
        if (!h2) break;
        if (done_word && flag[1]) { ret = n2; break; }
        it = n2;
    }
    asm volatile("s_waitcnt vmcnt(0)" ::: "memory");
    __syncthreads();
    return ret;
}
constexpr int NQ = NEX * I_EXP + NL1, NQ_L0E = NEX * I_EXP, NQ_L1D = NQ_L0E + NL1D, CW_DONE = 8256, CW_PEND = 8320, CVB = 8;
__device__ __forceinline__ void cv_fill(const Frame& F, const Args& args, int q_limit, gu32* done_word, unsigned done_target) {
    volatile LAS unsigned* slot = F.MISC + 32; gu32* pw = F.ctl + CW_PEND + 2 * F.b;
    for (;;) {
        if (F.tid == 0) { unsigned nxt = __hip_atomic_load(pw, RLX_AGENT), en = __hip_atomic_load(pw + 1, RLX_AGENT), ex = 0u;
            if (nxt >= en) {
                const bool stop = (done_word && __hip_atomic_load(done_word, RLX_AGENT) >= done_target) || __hip_atomic_load(F.ctl + CW_CVQ, RLX_AGENT) >= (unsigned)q_limit;
                if (stop) ex = 1u;
                else { nxt = __hip_atomic_fetch_add(F.ctl + CW_CVQ, (unsigned)CVB, RLX_AGENT);
                    if (nxt >= (unsigned)NQ) ex = 1u; else { en = nxt + CVB < (unsigned)NQ ? nxt + CVB : (unsigned)NQ; __hip_atomic_store(pw + 1, en, RLX_AGENT); __hip_atomic_store(pw, nxt, RLX_AGENT); } } }
            slot[0] = nxt; slot[1] = en; slot[2] = ex; }
        __syncthreads();
        const unsigned nxt = slot[0], en = slot[1], ex = slot[2];
        __syncthreads();
        if (ex) break;
        const int r = cv_run_seq(F, args, NL0D + (int)nxt, 1, NL0D + (int)en, done_word, done_target) - NL0D;
        if (F.tid == 0) __hip_atomic_store(pw, (unsigned)r, RLX_AGENT);
        if (r < (int)en) break;
    }
}
__device__ __forceinline__ void p0_prologue(Frame& F, const Args& args) {
    const int gw = F.b * NWAVES + F.wave, NGW = F.G * NWAVES, lane = F.lane;
    { LAS f32x4* red = (LAS f32x4*)(F.lds + RING_OFF);
      LAS float* sl = (LAS float*)(F.lds + RING_OFF + 32768);
      for (int i = F.tid; i < 2 * D; i += 512) { const float a = i < D ? INP(1)[i] : INP(3)[i - D]; sl[i] = a / (1.f + __expf(-a)); }
      __syncthreads();
      for (int it = F.b; it < 768; it += F.G) {
        const int l = it / 384, kc = (it % 384) / 48, cg = it % 48, k0 = kc * 256 + 32 * F.wave;
        const gf32* W = INP(4) + (size_t)l * D * 12288 + (size_t)k0 * 12288 + cg * 256 + lane * 4;
        f32x4 al = {0.f, 0.f, 0.f, 0.f}, ac = {0.f, 0.f, 0.f, 0.f};
#pragma unroll 16
        for (int k = 0; k < 32; ++k) { const f32x4 w = *(const GAS f32x4*)(W + (size_t)k * 12288);
            al += w * sl[k0 + k]; ac += w * sl[D + k0 + k]; }
        red[(F.wave * 2) * 64 + lane] = al; red[(F.wave * 2 + 1) * 64 + lane] = ac;
        __syncthreads();
        if (F.tid < 128) { const int vv = F.tid >> 6; f32x4 s = red[vv * 64 + lane];
#pragma unroll
            for (int ww = 1; ww < 8; ++ww) s += red[(ww * 2 + vv) * 64 + lane];
            *(GAS f32x4*)((gf32*)(F.ws + WS_PART) + (size_t)((l * 8 + kc) * 2 + vv) * 12288 + cg * 256 + lane * 4) = s; }
        __syncthreads();
      } }
    for (int t = gw; t < T; t += NGW) {
        float cm = 1.f, sm = 0.f, cg_ = 1.f, sg = 0.f;
        if (t >= CTX) { const int p = t - CTX; const float row = (float)(p / 64), col = (float)(p % 64);
            { const int i = lane & 31, ii = i & 15; const float inv = powf(10000.f, -(float)ii / 16.f); const float ang = (i < 16 ? row : col) * inv; sincosf(ang, &sm, &cm); }
            { const int i = lane, ii = i & 31; const float inv = powf(10000.f, -(float)ii / 32.f); const float ang = (i < 32 ? row : col) * inv; sincosf(ang, &sg, &cg_); } }
        if (lane < 32) *(GAS f32x2*)((gf32*)(F.ws + WS_TABM) + ((size_t)t * 32 + lane) * 2) = (f32x2){cm, sm};
        *(GAS f32x2*)((gf32*)(F.ws + WS_TABG) + ((size_t)t * 64 + lane) * 2) = (f32x2){cg_, sg};
    }
    { GAS u32x4* z = (GAS u32x4*)(F.ws + WS_WIN + (size_t)NIN * D * 2); const int n16 = (NINP - NIN) * D * 2 / 16;
      for (int i = F.b * 512 + F.tid; i < n16; i += F.G * 512) z[i] = (u32x4){0u, 0u, 0u, 0u}; }
    for (int idx = F.b * 512 + F.tid; idx < 2 * NE * D; idx += F.G * 512) { const int l = idx / (NE * D), e = (idx / D) % NE, k = idx % D;
        const float w = INP(19)[((size_t)l * D + k) * NE + e]; const unsigned hi = f2bf(w); const float lo = w - bf2f_lo(hi);
        gbf* o = (gbf*)(F.ws + WS_WRT) + (size_t)l * 2 * NE * D + (size_t)e * D + k; o[0] = (bf16_t)hi; o[(size_t)NE * D] = (bf16_t)f2bf(lo); }
    cv_run_seq(F, args, F.b, F.G, NL0D);
}

__device__ __forceinline__ void norm_mod_store(const f32x4 (&v)[8], const gf32* g, const gf32* shift, const gf32* scale, gbf* dst, int lane) {
    float ss = 0.f;
#pragma unroll
    for (int j = 0; j < 8; ++j) ss += (v[j][0] * v[j][0] + v[j][1] * v[j][1]) + (v[j][2] * v[j][2] + v[j][3] * v[j][3]);
    const float rs = rsqrtf(wave_sum(ss) * (1.f / D) + EPS);
#pragma unroll
    for (int j = 0; j < 8; ++j) { const int c = 4 * lane + 256 * j;
        const f32x4 gg = *(const GAS f32x4*)(g + c), sh = *(const GAS f32x4*)(shift + c), sc = *(const GAS f32x4*)(scale + c);
        const f32x4 y = v[j] * rs * gg, h = y * (sc + 1.f) + sh;
        *(GAS u32x2*)(dst + c) = (u32x2){pk2(h[0], h[1]), pk2(h[2], h[3])}; }
}
__device__ __forceinline__ void p1_prenorm0(Frame& F, const Args& args) {
    const gf32* PART = (const gf32*)(F.ws + WS_PART); const gf32* ada_b = INP(5);
    { const int g = F.b * 512 + F.tid;
      if (g < 2 * 2 * 12288) { const int l = g / 24576, v = (g / 12288) % 2, j = g % 12288; float s = ada_b[l * 12288 + j];
#pragma unroll
          for (int kc = 0; kc < 8; ++kc) s += PART[(size_t)((l * 8 + kc) * 2 + v) * 12288 + j];
          ((gf32*)(F.ws + WS_MOD))[g] = s; } }
    LAS float* mv = (LAS float*)(F.lds + RING_OFF);
    for (int idx = F.tid; idx < 4 * D; idx += 512) { const int v = idx / (2 * D), j = idx % (2 * D); float s = ada_b[j];
#pragma unroll
        for (int kc = 0; kc < 8; ++kc) s += PART[(size_t)(kc * 2 + v) * 12288 + j];
        mv[idx] = s; }
    __syncthreads();
    const gf32* g = INP(6);
    for (int row = F.b * NWAVES + F.wave; row < T; row += F.G * NWAVES) {
        const int v = row < CTX ? 1 : 0; const gf32* src = row < CTX ? INP(2) + (size_t)row * D : INP(0) + (size_t)(row - CTX) * D;
        f32x4 x[8]; float ss = 0.f;
#pragma unroll
        for (int j = 0; j < 8; ++j) { x[j] = *(const GAS f32x4*)(src + 4 * F.lane + 256 * j); ss += (x[j][0] * x[j][0] + x[j][1] * x[j][1]) + (x[j][2] * x[j][2] + x[j][3] * x[j][3]); }
        const float rs = rsqrtf(wave_sum(ss) * (1.f / D) + EPS);
        gbf* dst = (gbf*)(F.ws + WS_XS) + (size_t)row * D;
#pragma unroll
        for (int j = 0; j < 8; ++j) { const int c = 4 * F.lane + 256 * j;
            const f32x4 gg = *(const GAS f32x4*)(g + c), sh = *(const LAS f32x4*)(mv + v * 2 * D + c), sc = *(const LAS f32x4*)(mv + v * 2 * D + D + c);
            const f32x4 y = x[j] * rs * gg, h = y * (sc + 1.f) + sh;
            *(GAS u32x2*)(dst + c) = (u32x2){pk2(h[0], h[1]), pk2(h[2], h[3])}; }
    }
    __syncthreads();
}
__device__ __forceinline__ void p3_small(Frame& F, const Args& args) {
    const gbf* QKV = (const gbf*)(F.ws + WS_QKV); gf32* rs = (gf32*)(F.ws + WS_RS); gbf* KF = (gbf*)(F.ws + WS_KF); const gf32* tab = (const gf32*)(F.ws + WS_TABM);
    for (int t = F.b * NWAVES + F.wave; t < T; t += F.G * NWAVES) {
        const gbf* row = QKV + (size_t)t * NINP;
        const u32x4 a = *(const GAS u32x4*)(row + 3072 + 8 * F.lane), b = *(const GAS u32x4*)(row + 3584 + 8 * F.lane);
        float sa = 0.f, sb = 0.f;
#pragma unroll
        for (int i = 0; i < 4; ++i) { const float a0 = bf2f_lo(a[i]), a1 = bf2f_hi(a[i]), b0 = bf2f_lo(b[i]), b1 = bf2f_hi(b[i]); sa += a0 * a0 + a1 * a1; sb += b0 * b0 + b1 * b1; }
        sa = wave_sum(sa); sb = wave_sum(sb);
        if (F.lane == 0) { rs[t] = rsqrtf(sa * (1.f / 512.f) + EPS); rs[T + t] = rsqrtf(sb * (1.f / 512.f) + EPS); }
        if (F.lane < 32) { const unsigned w = *(const GAS unsigned*)(row + 4096 + 2 * F.lane); const float x1 = bf2f_lo(w), x2 = bf2f_hi(w);
            const f32x2 cs = *(const GAS f32x2*)(tab + ((size_t)t * 32 + F.lane) * 2);
            const unsigned o = pk2(x1 * cs[0] - x2 * cs[1], x1 * cs[1] + x2 * cs[0]);
#pragma unroll
            for (int h = 0; h < 8; ++h) *(GAS unsigned*)(KF + (size_t)t * 1536 + h * 192 + 128 + 2 * F.lane) = o; }
    }
}
__device__ __forceinline__ void p13_qknorm(Frame& F, const Args& args) {
    gbf* QKV = (gbf*)(F.ws + WS_QKV); const gf32* tab = (const gf32*)(F.ws + WS_TABG);
    const int sub = F.lane & 15;
    for (int t = F.b * NWAVES + F.wave; t < T; t += F.G * NWAVES) {
#pragma unroll
        for (int it = 0; it < 5; ++it) { const int head = it * 4 + (F.lane >> 4);
            gbf* p = QKV + (size_t)t * 3072 + head * 128 + sub * 8;
            const u32x4 w = *(const GAS u32x4*)p; float x[8];
#pragma unroll
            for (int i = 0; i < 4; ++i) { x[2 * i] = bf2f_lo(w[i]); x[2 * i + 1] = bf2f_hi(w[i]); }
            float ss = 0.f;
#pragma unroll
            for (int i = 0; i < 8; ++i) ss += x[i] * x[i];
            ss += __shfl_xor(ss, 1); ss += __shfl_xor(ss, 2); ss += __shfl_xor(ss, 4); ss += __shfl_xor(ss, 8);
            const float rs = rsqrtf(ss * (1.f / 128.f) + EPS);
            const gf32* g = (head < 16 ? INP(16) : INP(17)) + sub * 8;
            const f32x4 g0 = *(const GAS f32x4*)g, g1 = *(const GAS f32x4*)(g + 4);
#pragma unroll
            for (int i = 0; i < 4; ++i) { x[i] = x[i] * rs * g0[i]; x[4 + i] = x[4 + i] * rs * g1[i]; }
            const f32x4 t0 = *(const GAS f32x4*)(tab + ((size_t)t * 64 + sub * 4) * 2), t1 = *(const GAS f32x4*)(tab + ((size_t)t * 64 + sub * 4 + 2) * 2);
            u32x4 o;
            o.x = pk2(x[0] * t0[0] - x[1] * t0[1], x[0] * t0[1] + x[1] * t0[0]); o.y = pk2(x[2] * t0[2] - x[3] * t0[3], x[2] * t0[3] + x[3] * t0[2]);
            o.z = pk2(x[4] * t1[0] - x[5] * t1[1], x[4] * t1[1] + x[5] * t1[0]); o.w = pk2(x[6] * t1[2] - x[7] * t1[3], x[6] * t1[3] + x[7] * t1[2]);
            *(GAS u32x4*)p = o; }
    }
}

__device__ __forceinline__ void moe_router(Frame& F, const Args& args, int l) {
    const int row_off = l ? CTX : 0, per = l ? 32 : 33; const bool EX = (l == 0);
    const int tid = F.tid, lane = F.lane, w = F.wave, i = lane & 31, hh = lane >> 5;
    LAS float* part = (LAS float*)(F.lds + RING_OFF);
    LAS float* logits = (LAS float*)(F.lds + RING_OFF + 65536);
    LAS float* red = (LAS float*)(F.lds + RING_OFF + 65536 + 16384);
    LAS float* redx = red + 256;
    LAS float* partx = red + 512;
    volatile LAS unsigned* hist = F.MISC + 64;
    if (tid < 64) hist[tid] = 0u;
    __syncthreads();
    const gbf* X1 = (const gbf*)(F.ws + WS_X1); gbf* XS = (gbf*)(F.ws + WS_XS);
    const gf32* fn = INP(7) + (size_t)l * D; const gf32* Wr = INP(19) + (size_t)l * D * NE; const gf32* rb = INP(20) + l * NE;
    gu32* tok_e = (gu32*)(F.ws + WS_TOKE); gf32* tok_w = (gf32*)(F.ws + WS_TOKW); gu32* tok_s = (gu32*)(F.ws + WS_TOKS);
    for (int g = F.b; g < 256; g += F.G) {
        const int t0 = g * per, t = t0 + i, tx = t0 + 32;
        const bool v = (l == 0 && t < CTX), vx = (l == 0 && tx < CTX);
        const int ko = 256 * w + 8 * hh;
        const gbf* xrow = X1 + (size_t)(row_off + t) * D + ko; const gbf* xrx = X1 + (size_t)(row_off + tx) * D + ko;
        const gf32* shp = (v ? MODP(F, l, 1, 3) : MODP(F, l, 0, 3)) + ko; const gf32* scp = (v ? MODP(F, l, 1, 4) : MODP(F, l, 0, 4)) + ko; const gf32* fnp = fn + ko;
        const gf32* shx = (vx ? MODP(F, l, 1, 3) : MODP(F, l, 0, 3)) + ko; const gf32* scx = (vx ? MODP(F, l, 1, 4) : MODP(F, l, 0, 4)) + ko;
        float ss = 0.f, ssx = 0.f;
#pragma unroll 4
        for (int s = 0; s < 16; ++s) { f32x4 x0, x1; x1_ld8(xrow + 16 * s, x0, x1);
            ss += ((x0[0] * x0[0] + x0[1] * x0[1]) + (x0[2] * x0[2] + x0[3] * x0[3])) + ((x1[0] * x1[0] + x1[1] * x1[1]) + (x1[2] * x1[2] + x1[3] * x1[3]));
            if (EX) { f32x4 y0, y1; x1_ld8(xrx + 16 * s, y0, y1);
                ssx += ((y0[0] * y0[0] + y0[1] * y0[1]) + (y0[2] * y0[2] + y0[3] * y0[3])) + ((y1[0] * y1[0] + y1[1] * y1[1]) + (y1[2] * y1[2] + y1[3] * y1[3])); } }
        ss += __shfl_xor(ss, 32); ssx += __shfl_xor(ssx, 32);
        if (hh == 0) red[w * 32 + i] = ss;
        if (lane == 0) redx[w] = ssx;
        __syncthreads();
        float tot = 0.f, totx = 0.f;
#pragma unroll
        for (int q = 0; q < 8; ++q) { tot += red[q * 32 + i]; totx += redx[q]; }
        const float rs = rsqrtf(tot * (1.f / D) + EPS), rsx = rsqrtf(totx * (1.f / D) + EPS);
        f32x16 acc0 = {}, acc1 = {}; float ax0 = 0.f, ax1 = 0.f;
        gbf* xs = XS + (size_t)t * D + ko; gbf* xsx = XS + (size_t)tx * D + ko;
        const gbf* wt0 = (const gbf*)(F.ws + WS_WRT) + (size_t)l * 2 * NE * D + (size_t)i * D + ko;
#pragma unroll 2
        for (int s = 0; s < 16; ++s) {
            f32x4 h0, h1;
            { f32x4 x0, x1; x1_ld8(xrow + 16 * s, x0, x1);
              const f32x4 g0 = *(const GAS f32x4*)(fnp + 16 * s), g1 = *(const GAS f32x4*)(fnp + 16 * s + 4);
              h0 = (x0 * rs * g0) * (*(const GAS f32x4*)(scp + 16 * s) + 1.f) + *(const GAS f32x4*)(shp + 16 * s);
              h1 = (x1 * rs * g1) * (*(const GAS f32x4*)(scp + 16 * s + 4) + 1.f) + *(const GAS f32x4*)(shp + 16 * s + 4);
              if (EX) { f32x4 y0, y1; x1_ld8(xrx + 16 * s, y0, y1);
                  const f32x4 hx0 = (y0 * rsx * g0) * (*(const GAS f32x4*)(scx + 16 * s) + 1.f) + *(const GAS f32x4*)(shx + 16 * s);
                  const f32x4 hx1 = (y1 * rsx * g1) * (*(const GAS f32x4*)(scx + 16 * s + 4) + 1.f) + *(const GAS f32x4*)(shx + 16 * s + 4);
                  if (i == 0) *(GAS u32x4*)(xsx + 16 * s) = (u32x4){pk2(hx0[0], hx0[1]), pk2(hx0[2], hx0[3]), pk2(hx1[0], hx1[1]), pk2(hx1[2], hx1[3])};
#pragma unroll
                  for (int c = 0; c < 2; ++c) { const u32x4 wh = *(const GAS u32x4*)(wt0 + (size_t)c * 32 * D + 16 * s), wl = *(const GAS u32x4*)(wt0 + (size_t)(NE + c * 32) * D + 16 * s);
                      float a = 0.f;
#pragma unroll
                      for (int q = 0; q < 4; ++q) { const float w0 = bf2f_lo(wh[q]) + bf2f_lo(wl[q]), w1 = bf2f_hi(wh[q]) + bf2f_hi(wl[q]);
                          const float e0 = q < 2 ? hx0[2 * q] : hx1[2 * q - 4], e1 = q < 2 ? hx0[2 * q + 1] : hx1[2 * q - 3]; a = fmaf(e0, w0, a); a = fmaf(e1, w1, a); }
                      if (c == 0) ax0 += a; else ax1 += a; } } }
            const u32x4 hhi = {pk2(h0[0], h0[1]), pk2(h0[2], h0[3]), pk2(h1[0], h1[1]), pk2(h1[2], h1[3])};
            *(GAS u32x4*)(xs + 16 * s) = hhi;
            u32x4 hlo;
            hlo[0] = pk2(h0[0] - bf2f_lo(hhi[0]), h0[1] - bf2f_hi(hhi[0])); hlo[1] = pk2(h0[2] - bf2f_lo(hhi[1]), h0[3] - bf2f_hi(hhi[1]));
            hlo[2] = pk2(h1[0] - bf2f_lo(hhi[2]), h1[1] - bf2f_hi(hhi[2])); hlo[3] = pk2(h1[2] - bf2f_lo(hhi[3]), h1[3] - bf2f_hi(hhi[3]));
            const bf16x8 ahi = __builtin_bit_cast(bf16x8, hhi), alo = __builtin_bit_cast(bf16x8, hlo);
            { const bf16x8 bh = *(const GAS bf16x8*)(wt0 + 16 * s), bl = *(const GAS bf16x8*)(wt0 + (size_t)NE * D + 16 * s);
              acc0 = __builtin_amdgcn_mfma_f32_32x32x16_bf16(ahi, bh, acc0, 0, 0, 0); acc0 = __builtin_amdgcn_mfma_f32_32x32x16_bf16(ahi, bl, acc0, 0, 0, 0); acc0 = __builtin_amdgcn_mfma_f32_32x32x16_bf16(alo, bh, acc0, 0, 0, 0); }
            { const bf16x8 bh = *(const GAS bf16x8*)(wt0 + (size_t)32 * D + 16 * s), bl = *(const GAS bf16x8*)(wt0 + (size_t)(NE + 32) * D + 16 * s);
              acc1 = __builtin_amdgcn_mfma_f32_32x32x16_bf16(ahi, bh, acc1, 0, 0, 0); acc1 = __builtin_amdgcn_mfma_f32_32x32x16_bf16(ahi, bl, acc1, 0, 0, 0); acc1 = __builtin_amdgcn_mfma_f32_32x32x16_bf16(alo, bh, acc1, 0, 0, 0); }
        }
#pragma unroll
        for (int r = 0; r < 16; ++r) { const int row = (r & 3) + 8 * (r >> 2) + 4 * hh; part[(w * 32 + row) * 64 + i] = acc0[r]; part[(w * 32 + row) * 64 + 32 + i] = acc1[r]; }
        if (EX) { ax0 += __shfl_xor(ax0, 32); ax1 += __shfl_xor(ax1, 32); if (hh == 0) { partx[w * 64 + i] = ax0; partx[w * 64 + 32 + i] = ax1; } }
        __syncthreads();
#pragma unroll
        for (int q = 0; q < 4; ++q) { const int idx = tid + 512 * q; float s = 0.f;
#pragma unroll
            for (int ww = 0; ww < 8; ++ww) s += part[ww * 2048 + idx];
            logits[idx] = s; }
        if (EX && tid < 64) { float s = 0.f;
#pragma unroll
            for (int ww = 0; ww < 8; ++ww) s += partx[ww * 64 + tid];
            logits[2048 + tid] = s; }
        __syncthreads();
        const int nq = (EX && w == 0) ? 5 : 4;
#pragma unroll 1
        for (int q = 0; q < nq; ++q) {
            const int ti = q < 4 ? 4 * w + q : 32, tt = t0 + ti;
            const float lg = logits[ti * 64 + lane], score = 1.f / (1.f + __expf(-lg)), sel = score + rb[lane];
            int rank = 0;
#pragma unroll
            for (int d = 1; d < 8; ++d) { const float o = __shfl_xor(sel, d); rank += ((o > sel) || (o == sel && (lane ^ d) < lane)) ? 1 : 0; }
            float gsum = rank < 2 ? sel : 0.f;
            gsum += __shfl_xor(gsum, 1); gsum += __shfl_xor(gsum, 2); gsum += __shfl_xor(gsum, 4);
            int grank = 0; const int gi = lane >> 3;
#pragma unroll
            for (int m = 1; m < 8; ++m) { const float o = __shfl_xor(gsum, 8 * m); grank += ((o > gsum) || (o == gsum && (gi ^ m) < gi)) ? 1 : 0; }
            const bool gsel = grank < 4;
            const float msk = gsel ? sel : -__builtin_inff();
            int erank = 0;
#pragma unroll 8
            for (int j = 0; j < 64; ++j) { const float o = __shfl(msk, j); erank += ((o > msk) || (o == msk && j < lane)) ? 1 : 0; }
            const bool chosen = gsel && erank < TOPK;
            const float ssum = wave_sum(chosen ? score : 0.f);
            if (chosen) { tok_e[(size_t)tt * 8 + erank] = (unsigned)lane; tok_w[(size_t)tt * 8 + erank] = score / ssum * 2.5f;
                tok_s[(size_t)tt * 8 + erank] = __hip_atomic_fetch_add((LAS unsigned*)&hist[lane], 1u, __ATOMIC_RELAXED, __HIP_MEMORY_SCOPE_WORKGROUP); }
        }
        __syncthreads();
    }
    __syncthreads();
    const int Tn = l ? SEQ : T;
    volatile LAS unsigned* base = F.MISC + 128; volatile LAS unsigned* cntl = F.MISC + 192; volatile LAS unsigned* bstart = F.MISC + 1280;
    if (tid < 64) { const unsigned c = hist[tid]; bstart[tid] = c ? __hip_atomic_fetch_add(F.ctl + CW_CNT + 256 * l + tid, c, RLX_AGENT) : 0u; }
    __syncthreads();
    if (tid == 0) { gu32* arr = F.ctl + CW_ARR + 64 * l; unsigned* xb = (unsigned*)F.ctl + CW_BAR;
        __hip_atomic_fetch_add(arr, 1u, RLX_AGENT);
        unsigned sp = 0u;
        while (__hip_atomic_load(arr, RLX_AGENT) < (unsigned)F.G) { __builtin_amdgcn_s_sleep(1);
            if ((++sp & 255u) == 0u) { if (xb_ld(&xb[XB_TMO])) break; if (sp > XB_SPIN_CAP) { atomicAdd(&xb[XB_TMO], 1u); break; } } } }
    __syncthreads();
    GAS int* slot_t = (GAS int*)(F.ws + WS_SLOTT); gf32* slot_w = (gf32*)(F.ws + WS_SLOTW);
    if (tid < 64) {
        const unsigned c = __hip_atomic_load(F.ctl + CW_CNT + 256 * l + lane, RLX_AGENT), p = (c + 255u) / 256u;
        unsigned inc = p;
#pragma unroll
        for (int o = 1; o < 64; o <<= 1) { const unsigned y = __shfl_up(inc, o); if (lane >= o) inc += y; }
        const unsigned exc = inc - p, total = __shfl(inc, 63);
        base[lane] = (unsigned)Tn + 256u * exc; cntl[lane] = c;
        if (F.b == 0) { GAS int* te = (GAS int*)(F.ws + WS_TILEE) + l * 1024; const int pm0 = Tn / 256;
            for (int q = lane; q < pm0; q += 64) te[16 + q] = 0;
            for (unsigned q = 0; q < p; ++q) te[16 + pm0 + exc + q] = lane + 1;
            if (lane == 0) te[0] = pm0 + (int)total; }
    }
    __syncthreads();
    if (F.b < NE) { const unsigned c = cntl[F.b], b0 = base[F.b], pe = (c + 255u) / 256u * 256u;
        for (unsigned q = c + tid; q < pe; q += 512) slot_t[b0 + q] = 0; }
    for (int g = F.b; g < 256; g += F.G) {
        const int t0 = g * per;
        for (int p = tid; p < per * 9; p += 512) { const int ti = p / 9, k = p % 9, t = t0 + ti;
            if (k == 8) { slot_w[t] = 1.f; slot_t[t] = t; }
            else { const unsigned e = tok_e[(size_t)t * 8 + k]; const unsigned pos = base[e] + bstart[e] + tok_s[(size_t)t * 8 + k];
                tok_s[(size_t)t * 8 + k] = pos; slot_w[pos] = tok_w[(size_t)t * 8 + k]; slot_t[pos] = t; } } }
}
__device__ __forceinline__ void moe_combine(Frame& F, const Args& args, int l) {
    const int Tn = l ? SEQ : T, row_off = l ? CTX : 0, lane = F.lane;
    const GAS unsigned char* YS = F.ws + WS_YS; gbf* X1 = (gbf*)(F.ws + WS_X1); const gu32* tok_s = (const gu32*)(F.ws + WS_TOKS);
    for (int t = F.b * NWAVES + F.wave; t < Tn; t += F.G * NWAVES) {
        const int v = (l == 0 && t < CTX) ? 1 : 0; const gf32* gate = MODP(F, l, v, 5);
        unsigned sl = 0u; if (lane < 8) sl = tok_s[(size_t)t * 8 + lane];
        unsigned rows[9]; rows[0] = (unsigned)t;
#pragma unroll
        for (int k = 0; k < 8; ++k) rows[1 + k] = __shfl(sl, k);
        gbf* xr = X1 + (size_t)(row_off + t) * D;
        LAS float* xl = (LAS float*)(F.lds + RING_OFF) + F.wave * D;
        float ss = 0.f;
#pragma unroll
        for (int j = 0; j < 2; ++j) { const int c = 16 * lane + 1024 * j; float a[16];
#pragma unroll
            for (int q = 0; q < 16; ++q) a[q] = 0.f;
#pragma unroll
            for (int k = 0; k < 9; ++k) { const u32x4 y = *(const GAS u32x4*)(YS + (size_t)rows[k] * D + c);
#pragma unroll
                for (int q = 0; q < 4; ++q) { const f32x2 lo = __builtin_amdgcn_cvt_pk_f32_fp8((int)y[q], false), hi = __builtin_amdgcn_cvt_pk_f32_fp8((int)y[q], true);
                    a[4 * q] += lo[0]; a[4 * q + 1] += lo[1]; a[4 * q + 2] += hi[0]; a[4 * q + 3] += hi[1]; } }
#pragma unroll
            for (int q = 0; q < 4; ++q) { const f32x4 x = x1_ld4(xr + c + 4 * q), g = *(const GAS f32x4*)(gate + c + 4 * q) * (1.f / pg8::YS_SCALE);
                const f32x4 y = x + g * (f32x4){a[4 * q], a[4 * q + 1], a[4 * q + 2], a[4 * q + 3]};
                ss += (y[0] * y[0] + y[1] * y[1]) + (y[2] * y[2] + y[3] * y[3]);
                *(LAS f32x4*)(xl + c + 4 * q) = y;
                if (l == 0) x1_st4(xr + c + 4 * q, y); } }
        const float rs = rsqrtf(wave_sum(ss) * (1.f / D) + EPS);
        if (l == 0) {
            const gf32* g = INP(6) + D; const gf32* sh = MODP(F, 1, v, 0); const gf32* sc = MODP(F, 1, v, 1); gbf* dst = (gbf*)(F.ws + WS_XS) + (size_t)t * D;
#pragma unroll 1
            for (int j = 0; j < 2; ++j) { const int c = 16 * lane + 1024 * j; float h[16];
#pragma unroll
                for (int hq = 0; hq < 4; ++hq) { const f32x4 x = *(const LAS f32x4*)(xl + c + 4 * hq), gg = *(const GAS f32x4*)(g + c + 4 * hq), s1 = *(const GAS f32x4*)(sc + c + 4 * hq), s0 = *(const GAS f32x4*)(sh + c + 4 * hq);
                    const f32x4 y = (x * rs * gg) * (s1 + 1.f) + s0; h[4 * hq] = y[0]; h[4 * hq + 1] = y[1]; h[4 * hq + 2] = y[2]; h[4 * hq + 3] = y[3]; }
                *(GAS u32x4*)(dst + c) = (u32x4){pk2(h[0], h[1]), pk2(h[2], h[3]), pk2(h[4], h[5]), pk2(h[6], h[7])};
                *(GAS u32x4*)(dst + c + 8) = (u32x4){pk2(h[8], h[9]), pk2(h[10], h[11]), pk2(h[12], h[13]), pk2(h[14], h[15])}; }
        } else {
            const gf32* g = INP(27); gf32* o = F.out + (size_t)t * D;
#pragma unroll 1
            for (int j = 0; j < 2; ++j) { const int c = 16 * lane + 1024 * j;
#pragma unroll
                for (int hq = 0; hq < 4; ++hq) { const f32x4 x = *(const LAS f32x4*)(xl + c + 4 * hq), gg = *(const GAS f32x4*)(g + c + 4 * hq);
                    *(GAS f32x4*)(o + c + 4 * hq) = x * rs * gg; } }
        }
    }
}

#if MK_ONE_LAUNCH
#define GRID_BAR() xcd_barrier(bar)
#else
#define GRID_BAR() do {} while (0)
#endif
#define IN(k) (lo <= (k) && (k) < hi)
#define BOTH(k) (IN(k) && IN((k) + 1))
#ifndef DBG_REP
#define DBG_REP 0
#endif
#define REP_BEGIN(k) for (int rep_ = 0; rep_ < 1 + ((DBG_REP >> (k)) & 1); ++rep_) { if (rep_) GRID_BAR();
#define REP_END() }
#ifndef FILL_BIG
#define FILL_BIG 4
#endif
#ifndef FILL_SMALL
#define FILL_SMALL 0
#endif
#define GP_OF(nun) ({ const int _n = (nun), _r = (_n + F.G - 1) / F.G; (_n + _r - 1) / _r; })
#define PHASE_DONE(k) do { if (F.tid == 0) __hip_atomic_fetch_add(F.ctl + CW_DONE + (k), 1u, RLX_AGENT); } while (0)
template <int l>
__device__ __forceinline__ void layer_phases(Frame& F, const Args& args, const XcdBarrier& bar, const int lo, const int hi) {
    LAS unsigned char* ring = F.lds + RING_OFF;
    constexpr int pb = l ? 12 : 2;
    if constexpr (l == 0) {
        if (IN(2)) {
            const int Gp = GP_OF((T / 256) * (NINP / 256));
            if (F.b < Gp) {
            pg8::Gemm g{D, D, D}; pg8::DenseOrder S{nullptr, T / 256, NINP / 256, Gp, F.b, (const GAS char*)(F.ws + WS_XS), (const GAS char*)(F.ws + WS_WIN), (size_t)256 * D * 2, (size_t)256 * D * 2};
            pg8::EpiIn E{(gbf*)(F.ws + WS_QKV), (gf32*)(F.ws + WS_RS), (gbf*)(F.ws + WS_KF), (const GAS f32x4*)(F.ws + WS_TABM), (LAS float*)(F.MISC + 2048)};
            pg8::gemm_phase(ring, g, S, E); PHASE_DONE(2);
            } else cv_fill(F, args, NQ, F.ctl + CW_DONE + 2, (unsigned)Gp);
            if (BOTH(2)) GRID_BAR();
        }
        if (IN(4)) {
            { pg8::Gemm g{NINP, 512, 512};
              pg8::UpOrder S{nullptr, T / 256, F.G, F.b, (const GAS char*)((gbf*)(F.ws + WS_QKV) + 3072), (const GAS char*)((gbf*)(F.ws + WS_QKV) + 3584), (const GAS char*)(F.ws + WS_WUQ), (const GAS char*)(F.ws + WS_WUKV), (size_t)256 * NINP * 2, (size_t)256 * 512 * 2};
              pg8::EpiUp E{pg8::EpiQRope{(gbf*)(F.ws + WS_QM), (const gf32*)(F.ws + WS_RS), (const GAS f32x4*)(F.ws + WS_TABM)}, pg8::EpiKV{(gbf*)(F.ws + WS_KF), (gbf*)(F.ws + WS_VM), (const gf32*)(F.ws + WS_RS)}};
              pg8::gemm_phase(ring, g, S, E); }
            if (BOTH(4)) GRID_BAR();
        }
    } else {
        if (IN(12)) {
            const int Gp = GP_OF((T / 256) * 12);
            if (F.b < Gp) {
            pg8::Gemm g{D, D, D}; pg8::DenseOrder S{nullptr, T / 256, 12, Gp, F.b, (const GAS char*)(F.ws + WS_XS), (const GAS char*)(F.ws + WS_WQKV), (size_t)256 * D * 2, (size_t)256 * D * 2};
            pg8::EpiQKNorm E{(gbf*)(F.ws + WS_QKV), INP(16), INP(17), (const GAS f32x4*)(F.ws + WS_TABG), (LAS float*)(F.MISC + 2048)};
            pg8::gemm_phase(ring, g, S, E); PHASE_DONE(12);
            } else cv_fill(F, args, NQ, F.ctl + CW_DONE + 12, (unsigned)Gp);
            if (BOTH(12)) GRID_BAR();
        }
    }
    constexpr int pa = pb + (l ? 2 : 3);
    if (IN(pa)) {
        LAS char* alds = (LAS char*)ring;
        REP_BEGIN(pa)
        if constexpr (l == 0) {
#ifndef DBG_NO_MLA
            for (int u = F.b; u < 256 + 8; u += F.G) {
                gbf* QM = (gbf*)(F.ws + WS_QM); gbf* KF = (gbf*)(F.ws + WS_KF); gbf* VM = (gbf*)(F.ws + WS_VM); gbf* AO = (gbf*)(F.ws + WS_AO);
                const bool main = u < 256; const int h = main ? (u & 7) : (u - 256), q0 = main ? CTX + 256 * (u >> 3) : 0, NT = main ? T / 64 : CTX / 64;
                if constexpr (MLA_PP) att::attn_pp<192, 1536, 1536, 1024, (MLA_QLDS ? MLA_NQR : 0), MLA_QLA>(QM + (size_t)q0 * 1536 + h * 192, KF + h * 192, VM + h * 128, AO + (size_t)q0 * D + 1024 + h * 128, NT, alds, att::DensePol{});
                else att::attn_body<192, 1536, 1536, 1024, MLA_PIPE, MLA_SDEPTH, (MLA_QLDS ? MLA_NQR : 0)>(QM + (size_t)q0 * 1536 + h * 192, KF + h * 192, VM + h * 128, AO + (size_t)q0 * D + 1024 + h * 128, NT, alds, att::DensePol{});
                __syncthreads();
            }
#endif
#ifndef DBG_NO_NA
            for (int u = F.b; u < 256; u += F.G) {
                gbf* QKV = (gbf*)(F.ws + WS_QKV); gbf* AO = (gbf*)(F.ws + WS_AO);
                LAS float* rpbs = (LAS float*)(ring + 110592);
                const int h = u & 7, ub = u >> 3, r_unit = 4 * ub; int rlo = r_unit - 4; rlo = rlo < 0 ? 0 : (rlo > 116 ? 116 : rlo);
                { int t2 = threadIdx.x; asm volatile("" : "+v"(t2));
                  for (int idx = t2; idx < 15 * 31; idx += 512) rpbs[idx] = INP(9)[(size_t)h * 465 + idx] * 11.313708498984761f; }
                __syncthreads();
                att::NaPol pol{r_unit, rlo, rpbs};
                const int q0 = CTX + 256 * ub;
                att::attn_body<128, NINP, NINP, NINP, false, 1, MLA_NQR>(QKV + (size_t)q0 * NINP + h * 128, QKV + 1024 + h * 128, QKV + 2048 + h * 128, AO + (size_t)q0 * D + h * 128, 16, alds, pol);
                __syncthreads();
            }
#endif
        }
        constexpr int nu = l ? 512 : 8;
        for (int u = l ? F.b : (F.b >= 8 ? F.b - 8 : nu); u < nu; u += F.G) {
            gbf* QKV = (gbf*)(F.ws + WS_QKV); gbf* AO = (gbf*)(F.ws + WS_AO);
            const gbf *q, *k, *v; gbf* o; int NT; constexpr int ld = l ? 3072 : NINP;
            if constexpr (l == 0) { const int h = u; q = QKV + h * 128; k = QKV + 1024 + h * 128; v = QKV + 2048 + h * 128; o = AO + h * 128; NT = CTX / 64; }
            else { const int x = u & 7, i = u >> 8, qb = (u & 255) >> 3, kvh = x & 3, h = 4 * kvh + 2 * (x >> 2) + i;
                q = QKV + (size_t)(CTX + 256 * qb) * 3072 + h * 128; k = QKV + 2048 + kvh * 128; v = QKV + 2560 + kvh * 128; o = AO + (size_t)(CTX + 256 * qb) * D + h * 128; NT = T / 64; }
            if constexpr (l == 1 && GQA_PP) att::attn_pp<128, ld, ld, ld, GQA_NQR, QLA>(q, k, v, o, NT, alds, att::DensePol{});
            else att::attn_body<128, ld, ld, ld, true, (l ? GQA_SDEPTH : 1), (l ? GQA_NQR : 0)>(q, k, v, o, NT, alds, att::DensePol{});
            __syncthreads();
        }
        REP_END()
        if (BOTH(pa)) GRID_BAR();
    }
    constexpr int po = pb + (l ? 3 : 4);
    if (IN(po)) {
        constexpr int nM = l ? SEQ / 256 : T / 256, ro = l ? CTX : 0;
        gf32* X1 = (gf32*)(F.ws + WS_X1);
        const int Gp = GP_OF(nM * 8);
        if (F.b < Gp) {
        pg8::Gemm g{D, D, D}; pg8::DenseOrder S{nullptr, nM, 8, Gp, F.b, (const GAS char*)((gbf*)(F.ws + WS_AO) + (size_t)ro * D), (const GAS char*)(F.ws + (l ? WS_WO : WS_WOUT)), (size_t)256 * D * 2, (size_t)256 * D * 2};
        pg8::EpiResid<(l == 1)> E{X1, l ? (const gf32*)X1 : INP(2), l ? (const gf32*)X1 : INP(0) - (size_t)CTX * D, MODP(F, l, 1, 2), MODP(F, l, 0, 2), ro};
        pg8::gemm_phase(ring, g, S, E); PHASE_DONE(po);
        } else cv_fill(F, args, NQ, F.ctl + CW_DONE + po, (unsigned)Gp);
        if (BOTH(po)) GRID_BAR();
    }
    constexpr int mb = l ? 16 : 7;
    if (IN(mb)) { moe_router(F, args, l); __syncthreads(); cv_fill(F, args, l ? NQ : NQ_L0E, nullptr, 0u); if (IN(mb + 2)) GRID_BAR(); }
    if (IN(mb + 2) || IN(mb + 3)) {
        LAS int* te = (LAS int*)(F.MISC + 256);
        const GAS int* teg = (const GAS int*)(F.ws + WS_TILEE) + l * 1024;
        const int ntiles = (int)__hip_atomic_load((const gu32*)teg, RLX_AGENT);
        for (int idx = F.tid; idx < ntiles && idx < 1000; idx += 512) te[idx] = (int)__hip_atomic_load((const gu32*)teg + 16 + idx, RLX_AGENT);
        __syncthreads();
        if (IN(mb + 2)) {
            const int Gp = GP_OF(ntiles * 4);
            if (F.b < Gp) {
            pg8::Gemm g{D, D, D}; pg8::GroupedOrder<true> S{(const GAS int*)(F.ws + WS_SLOTT), ntiles, 4, Gp, F.b, (const GAS char*)(F.ws + WS_XS), (const GAS char*)(F.ws + WS_GU + (size_t)l * NEX * GU_BYTES), (size_t)0, (size_t)256 * D * 2, GU_BYTES, te};
            pg8::EpiSwiGLU E{(gbf*)(F.ws + WS_HB), (const gf32*)(F.ws + WS_SLOTW)};
            pg8::gemm_phase(ring, g, S, E); PHASE_DONE(mb + 2);
            } else cv_fill(F, args, NQ, F.ctl + CW_DONE + mb + 2, (unsigned)Gp);
            if (BOTH(mb + 2)) GRID_BAR();
        }
        if (IN(mb + 3)) {
            const int Gp = GP_OF(ntiles * 8);
            if (F.b < Gp) {
            pg8::Gemm g{DE, DE, DE}; pg8::GroupedOrder<false> S{nullptr, ntiles, 8, Gp, F.b, (const GAS char*)(F.ws + WS_HB), (const GAS char*)(F.ws + WS_DN + (size_t)l * NEX * DN_BYTES), (size_t)256 * DE * 2, (size_t)256 * DE * 2, DN_BYTES, te};
            pg8::EpiFp8RS E{F.ws + WS_YS, (const gf32*)(F.ws + WS_SLOTW)};
            pg8::gemm_phase(ring, g, S, E); PHASE_DONE(mb + 3);
            } else cv_fill(F, args, NQ, F.ctl + CW_DONE + mb + 3, (unsigned)Gp);
            if (BOTH(mb + 3)) GRID_BAR();
        }
    }
    if (IN(mb + 4)) { if constexpr (l == 0) cv_fill(F, args, NQ_L1D, nullptr, 0u); moe_combine(F, args, l); if (l == 0 && BOTH(mb + 4)) GRID_BAR(); }
}

__global__ void __launch_bounds__(NWAVES * 64, 2) fwd(Args args) {
    extern __shared__ __attribute__((aligned(16))) unsigned char lds_raw[];
    Frame F;
    F.lds = (LAS unsigned char*)lds_raw; F.MISC = (volatile LAS unsigned*)(F.lds + MISC_OFF);
    F.tid = threadIdx.x; F.lane = F.tid & 63; F.wave = __builtin_amdgcn_readfirstlane(F.tid >> 6); F.b = blockIdx.x; F.G = gridDim.x;
    F.ws = (GAS unsigned char*)args.ws; F.ctl = (gu32*)(F.ws + WS_CTL); F.out = (gf32*)args.out;
    for (int u = F.tid; u < MISC_BYTES / 4; u += NWAVES * 64) F.MISC[u] = 0u;
    __syncthreads();
    XcdBarrier bar; bar.bar = (unsigned*)args.ws + CW_BAR; bar.x = 0; bar.st = nullptr;
#if MK_ONE_LAUNCH
    bar = xcd_barrier_post((unsigned*)args.ws + CW_BAR, F.MISC);
#endif
    const int lo = args.ph_lo, hi = args.ph_hi;
    if (IN(0)) { REP_BEGIN(0) p0_prologue(F, args); REP_END() if (BOTH(0)) GRID_BAR(); }
    if (IN(1)) { p1_prenorm0(F, args); if (BOTH(1)) GRID_BAR(); }
    layer_phases<0>(F, args, bar, lo, hi);
    layer_phases<1>(F, args, bar, lo, hi);
}
#undef IN
#undef BOTH

extern "C" void kernel_launch(void* const* d_in, const int* in_sizes, int n_in, void* d_out, int out_size, void* d_ws, size_t ws_size, hipStream_t stream) {
    static int grid = 0;
    if (grid == 0) {
        if (n_in != 28 || out_size != SEQ * D || ws_size < WS_END) { fprintf(stderr, "kernel_launch: shape mismatch n_in %d out %d ws %zu (need %zu)\n", n_in, out_size, ws_size, (size_t)WS_END); grid = -1; return; }
        int dev = 0, cus = 0, per_cu = 0;
        if (hipGetDevice(&dev) != hipSuccess || hipDeviceGetAttribute(&cus, hipDeviceAttributeMultiprocessorCount, dev) != hipSuccess) { grid = -1; return; }
        if (hipFuncSetAttribute((const void*)fwd, hipFuncAttributeMaxDynamicSharedMemorySize, LDS_BYTES) != hipSuccess) { fprintf(stderr, "kernel_launch: hipFuncSetAttribute failed\n"); grid = -1; return; }
        if (hipOccupancyMaxActiveBlocksPerMultiprocessor(&per_cu, (const void*)fwd, NWAVES * 64, LDS_BYTES) != hipSuccess || per_cu < 1) fprintf(stderr, "kernel_launch: occupancy query reports %d\n", per_cu);
        (void)hipGetLastError();
        grid = cus;
    }
    if (grid < 0) return;
    if (hipMemsetAsync((char*)d_ws + WS_CTL, 0, CTL_ZERO_BYTES, stream) != hipSuccess) return;
    Args a{};
    for (int i = 0; i < 28; ++i) a.in[i] = (const float*)d_in[i];
    a.out = (float*)d_out; a.ws = (unsigned char*)d_ws;
#if MK_ONE_LAUNCH
    a.ph_lo = 0; a.ph_hi = NPHASES;
    hipLaunchKernelGGL(fwd, dim3(grid), dim3(NWAVES * 64), LDS_BYTES, stream, a);
#else
    for (int p = 0; p < NPHASES; ++p) { a.ph_lo = p; a.ph_hi = p + 1; hipLaunchKernelGGL(fwd, dim3(grid), dim3(NWAVES * 64), LDS_BYTES, stream, a); }
#endif
}
```
